# Optimizing an MI355X kernel written in HIP

```python
import math
import jax
import jax.numpy as jnp
from jax import lax
import numpy as np

D_MODEL = 2048
BATCH = 4
SEQ = 2048
DEPTH = 1
DEC_BATCH = 128
DEC_SEQ = 4
PAST_LEN = 16384
PAGE_SIZE = 128

MIX_WIDTH = D_MODEL
W_A = MIX_WIDTH // 2
W_B = MIX_WIDTH - W_A
HGRN_EXPAND = 128
H_A = W_A // HGRN_EXPAND
DK = HGRN_EXPAND
DV = W_A // H_A
CHUNK = 64
S5_GROUP = 16
G_B = W_B // S5_GROUP
P_STATE = 64
D_FF = 4 * D_MODEL
IN_COLS = 4 * W_A + W_B
EPS = 1e-6

kernel_name = "hybrid_hgrn2_s5_decode_step"


def rmsnorm(x, g):
    xf = x.astype(jnp.float32)
    var = jnp.mean(xf * xf, axis=-1, keepdims=True)
    return xf * lax.rsqrt(var + EPS) * g.astype(jnp.float32)


def hgrn2_recurrence(q, k, v, logf, s0):
    b, t = q.shape[0], q.shape[1]
    c = min(CHUNK, t)
    n = -(-t // c)
    pad = n * c - t
    if pad:
        padw = ((0, 0), (0, pad), (0, 0), (0, 0))
        q, k, v, logf = [jnp.pad(a, padw) for a in (q, k, v, logf)]

    def to_chunks(a):
        return jnp.moveaxis(a.reshape(b, n, c, a.shape[2], a.shape[3]), 1, 0)

    qc, kc, vc, gc = map(to_chunks, (q, k, v, logf))
    causal = jnp.tril(jnp.ones((c, c), dtype=bool))[None, :, :, None, None]

    def step(s, inp):
        qi, ki, vi, gi = inp
        bcum = jnp.cumsum(gi, axis=1)
        o_inter = jnp.einsum('bthk,bhkv->bthv', qi * jnp.exp(bcum), s)
        diff = bcum[:, :, None] - bcum[:, None, :]
        decay = jnp.exp(jnp.where(causal, diff, -jnp.inf))
        scores = jnp.einsum('bthk,bshk,btshk->bhts', qi, ki, decay)
        o_intra = jnp.einsum('bhts,bshv->bthv', scores, vi)
        b_last = bcum[:, -1]
        k_dec = ki * jnp.exp(b_last[:, None] - bcum)
        s_new = jnp.exp(b_last)[..., None] * s + jnp.einsum('bshk,bshv->bhkv', k_dec, vi)
        return s_new, o_inter + o_intra

    s_final, oc = lax.scan(step, s0, (qc, kc, vc, gc))
    o = jnp.moveaxis(oc, 0, 1).reshape(b, n * c, H_A, DV)[:, :t]
    return o, s_final


def hgrn2_mixer(q_pre, f_pre, i_pre, g_pre, lb, norm_g, s0):
    bsz, t, _ = q_pre.shape
    q = jax.nn.silu(q_pre)
    f = lb + (1.0 - lb) * jax.nn.sigmoid(f_pre)
    k = 1.0 - f
    logf = jnp.log(f)
    o, s_new = hgrn2_recurrence(q.reshape(bsz, t, H_A, DK), k.reshape(bsz, t, H_A, DK),
                                i_pre.reshape(bsz, t, H_A, DV), logf.reshape(bsz, t, H_A, DK), s0)
    o = rmsnorm(o.reshape(bsz, t, W_A), norm_g) * jax.nn.silu(g_pre)
    return o, s_new


def s5_mixer(u, a_re, a_im, b_re, b_im, c_re, c_im, d, log_step, glu_w, glu_b, x0_re, x0_im):
    bsz, t, _ = u.shape
    f32 = jnp.float32
    a_re = a_re.astype(f32)
    a_im = a_im.astype(f32)
    dt = jnp.exp(log_step.astype(f32))[:, None]
    mag = jnp.exp(a_re * dt)
    lam_re, lam_im = mag * jnp.cos(a_im * dt), mag * jnp.sin(a_im * dt)
    den = a_re * a_re + a_im * a_im
    nr, ni = lam_re - 1.0, lam_im
    r_re = (nr * a_re + ni * a_im) / den
    r_im = (ni * a_re - nr * a_im) / den
    b_re = b_re.astype(f32)
    b_im = b_im.astype(f32)
    bb_re = r_re[..., None] * b_re - r_im[..., None] * b_im
    bb_im = r_re[..., None] * b_im + r_im[..., None] * b_re
    ug = u.reshape(bsz, t, G_B, S5_GROUP)
    bu_re = jnp.einsum('btgc,gpc->btgp', ug, bb_re)
    bu_im = jnp.einsum('btgc,gpc->btgp', ug, bb_im)
    bu_re = bu_re.at[:, 0].add(lam_re * x0_re - lam_im * x0_im)
    bu_im = bu_im.at[:, 0].add(lam_re * x0_im + lam_im * x0_re)
    a_el_re = jnp.broadcast_to(lam_re, bu_re.shape)
    a_el_im = jnp.broadcast_to(lam_im, bu_im.shape)

    def combine(e1, e2):
        a1r, a1i, b1r, b1i = e1
        a2r, a2i, b2r, b2i = e2
        return (a2r * a1r - a2i * a1i, a2r * a1i + a2i * a1r,
                a2r * b1r - a2i * b1i + b2r, a2r * b1i + a2i * b1r + b2i)

    _, _, xr, xi = lax.associative_scan(combine, (a_el_re, a_el_im, bu_re, bu_im), axis=1)
    y = (jnp.einsum('btgp,gcp->btgc', xr, c_re.astype(f32))
         - jnp.einsum('btgp,gcp->btgc', xi, c_im.astype(f32)))
    y = y.reshape(bsz, t, W_B) + d.astype(f32) * u
    y = jax.nn.gelu(y)
    y = y * jax.nn.sigmoid(y @ glu_w.astype(f32) + glu_b.astype(f32))
    return y, xr[:, -1], xi[:, -1]


def trunk_layer(x, s_hgrn0, x0_re, x0_im, lb, w_in, w_out, norm1_g, norm2_g, hgrn_norm_g,
                s5_a_re, s5_a_im, s5_b_re, s5_b_im, s5_c_re, s5_c_im, s5_d, s5_log_step,
                glu_w, glu_b, mlp_up, mlp_down):
    h = rmsnorm(x, norm1_g)
    proj = h @ w_in.astype(jnp.float32)
    q_pre, f_pre, i_pre, g_pre, u = jnp.split(proj, [W_A, 2 * W_A, 3 * W_A, 4 * W_A], axis=-1)
    o_a, s_a = hgrn2_mixer(q_pre, f_pre, i_pre, g_pre, lb, hgrn_norm_g, s_hgrn0.astype(jnp.float32))
    o_b, xr, xi = s5_mixer(u, s5_a_re, s5_a_im, s5_b_re, s5_b_im, s5_c_re, s5_c_im, s5_d,
                           s5_log_step, glu_w, glu_b,
                           x0_re.astype(jnp.float32), x0_im.astype(jnp.float32))
    mix = jnp.concatenate([o_a, o_b], axis=-1) @ w_out.astype(jnp.float32)
    x = x + mix.astype(x.dtype)
    h2 = rmsnorm(x, norm2_g)
    ff = jnp.square(jax.nn.relu(h2 @ mlp_up.astype(jnp.float32))) @ mlp_down.astype(jnp.float32)
    x = x + ff.astype(x.dtype)
    return x, s_a, xr, xi


def setup_inputs(seed: int = 0) -> dict:
    key = jax.random.key(seed)
    ks = jax.random.split(key, 32)
    f32 = jnp.float32
    nrm = lambda k, shape, s: jax.random.normal(k, shape, f32) * s
    n_idx = jnp.arange(P_STATE, dtype=f32)
    return {
        "x_prompt": nrm(ks[0], (BATCH, SEQ, D_MODEL), 1.0),
        "x_sample": nrm(ks[1], (DEC_BATCH, DEC_SEQ, D_MODEL), 1.0),
        "state_hgrn": nrm(ks[2], (DEPTH, DEC_BATCH, H_A, DK, DV), 0.5),
        "state_s5_re": nrm(ks[3], (DEPTH, DEC_BATCH, G_B, P_STATE), 0.1),
        "state_s5_im": nrm(ks[4], (DEPTH, DEC_BATCH, G_B, P_STATE), 0.1),
        "w_in": nrm(ks[5], (DEPTH, D_MODEL, IN_COLS), D_MODEL ** -0.5),
        "w_out": nrm(ks[6], (DEPTH, MIX_WIDTH, D_MODEL), MIX_WIDTH ** -0.5),
        "norm1_g": 1.0 + nrm(ks[7], (DEPTH, D_MODEL), 0.01),
        "norm2_g": 1.0 + nrm(ks[8], (DEPTH, D_MODEL), 0.01),
        "hgrn_lb_logits": nrm(ks[9], (DEPTH + 1, W_A), 0.1),
        "hgrn_norm_g": 1.0 + nrm(ks[10], (DEPTH, W_A), 0.01),
        "s5_a_re": -0.5 + nrm(ks[11], (DEPTH, G_B, P_STATE), 0.01),
        "s5_a_im": math.pi * n_idx + nrm(ks[12], (DEPTH, G_B, P_STATE), 0.01),
        "s5_b_re": nrm(ks[13], (DEPTH, G_B, P_STATE, S5_GROUP), (2 * S5_GROUP) ** -0.5),
        "s5_b_im": nrm(ks[14], (DEPTH, G_B, P_STATE, S5_GROUP), (2 * S5_GROUP) ** -0.5),
        "s5_c_re": nrm(ks[15], (DEPTH, G_B, S5_GROUP, P_STATE), P_STATE ** -0.5),
        "s5_c_im": nrm(ks[16], (DEPTH, G_B, S5_GROUP, P_STATE), P_STATE ** -0.5),
        "s5_d": nrm(ks[17], (DEPTH, W_B), 1.0),
        "s5_log_step": jax.random.uniform(ks[18], (DEPTH, G_B), f32, math.log(0.001), math.log(0.1)),
        "glu_w": nrm(ks[19], (DEPTH, W_B, W_B), W_B ** -0.5),
        "glu_b": nrm(ks[20], (DEPTH, W_B), 0.01),
        "mlp_up": nrm(ks[21], (DEPTH, D_MODEL, D_FF), D_MODEL ** -0.5),
        "mlp_down": nrm(ks[22], (DEPTH, D_FF, D_MODEL), D_FF ** -0.5),
        "final_norm_g": 1.0 + nrm(ks[23], (D_MODEL,), 0.01),
    }


def reference(x_prompt, x_sample, state_hgrn, state_s5_re, state_s5_im, w_in, w_out, norm1_g, norm2_g,
              hgrn_lb_logits, hgrn_norm_g, s5_a_re, s5_a_im, s5_b_re, s5_b_im, s5_c_re, s5_c_im, s5_d,
              s5_log_step, glu_w, glu_b, mlp_up, mlp_down, final_norm_g):
    f32 = jnp.float32
    lb_all = jnp.cumsum(jax.nn.softmax(hgrn_lb_logits.astype(f32), axis=0), axis=0)
    bp = x_prompt.shape[0]
    xp, xs = x_prompt, x_sample
    hp_list, rp_list, ip_list, hs_list, rs_list, is_list = [], [], [], [], [], []
    for l in range(DEPTH):
        shared = (lb_all[l], w_in[l], w_out[l], norm1_g[l], norm2_g[l], hgrn_norm_g[l],
                  s5_a_re[l], s5_a_im[l], s5_b_re[l], s5_b_im[l], s5_c_re[l], s5_c_im[l], s5_d[l],
                  s5_log_step[l], glu_w[l], glu_b[l], mlp_up[l], mlp_down[l])
        xp, sh_p, sr_p, si_p = trunk_layer(
            xp, jnp.zeros((bp, H_A, DK, DV), f32), jnp.zeros((bp, G_B, P_STATE), f32),
            jnp.zeros((bp, G_B, P_STATE), f32), *shared)
        xs, sh_s, sr_s, si_s = trunk_layer(xs, state_hgrn[l], state_s5_re[l], state_s5_im[l], *shared)
        hp_list.append(sh_p); rp_list.append(sr_p); ip_list.append(si_p)
        hs_list.append(sh_s); rs_list.append(sr_s); is_list.append(si_s)
    y_prompt = rmsnorm(xp, final_norm_g).astype(x_prompt.dtype)
    y_sample = rmsnorm(xs, final_norm_g).astype(x_sample.dtype)
    new_hgrn_prompt = jnp.stack(hp_list)
    new_s5_re_prompt = jnp.stack(rp_list)
    new_s5_im_prompt = jnp.stack(ip_list)
    new_hgrn_sample = jnp.stack(hs_list)
    new_s5_re_sample = jnp.stack(rs_list)
    new_s5_im_sample = jnp.stack(is_list)
    return (y_prompt, y_sample, new_hgrn_prompt, new_s5_re_prompt, new_s5_im_prompt,
            new_hgrn_sample, new_s5_re_sample, new_s5_im_sample)
```

```cpp
#include <hip/hip_runtime.h>
#include <cstdio>
#include <cstdint>
namespace nv {
constexpr int NTOK = 8704, NPROMPT = 8192, DM = 2048;
__device__ __forceinline__ float sigm(float v) { return 1.f / (1.f + expf(-v)); }
__device__ __forceinline__ float silu(float v) { return v / (1.f + expf(-v)); }
__device__ __forceinline__ float gelu_t(float v) { return 0.5f * v * (1.f + tanhf(0.7978845608028654f * (v + 0.044715f * v * v * v))); }

__global__ void __launch_bounds__(256) k_rms(const float* xp, const float* xs, const float* g, float* out, int D) {
    const int r = blockIdx.x; const float* src = r < NPROMPT ? xp + (size_t)r * D : xs + (size_t)(r - NPROMPT) * D;
    __shared__ float red[256];
    float s = 0.f; for (int i = threadIdx.x; i < D; i += 256) { float v = src[i]; s += v * v; }
    red[threadIdx.x] = s; __syncthreads();
    for (int o = 128; o > 0; o >>= 1) { if ((int)threadIdx.x < o) red[threadIdx.x] += red[threadIdx.x + o]; __syncthreads(); }
    const float rstd = rsqrtf(red[0] / (float)D + 1e-6f);
    for (int i = threadIdx.x; i < D; i += 256) { float v = src[i]; out[(size_t)r * D + i] = v * rstd * g[i]; }
}

template <int MODE> __global__ void __launch_bounds__(256) sgemm(const float* A, const float* B, float* C, int K, int lda, int ldb, int ldc) {
    __shared__ float As[16][132]; __shared__ float Bs[16][132];
    const int tid = threadIdx.x, tx = tid & 15, ty = tid >> 4;
    const int m0 = blockIdx.y * 128, n0 = blockIdx.x * 128;
    float acc[8][8];
#pragma unroll
    for (int i = 0; i < 8; ++i)
#pragma unroll
        for (int j = 0; j < 8; ++j) acc[i][j] = 0.f;
    const int ar = tid >> 1, ak = (tid & 1) * 8, bk = tid >> 4, bc = (tid & 15) * 8;
    for (int k0 = 0; k0 < K; k0 += 16) {
        const float4 a0 = *(const float4*)(A + (size_t)(m0 + ar) * lda + k0 + ak), a1 = *(const float4*)(A + (size_t)(m0 + ar) * lda + k0 + ak + 4);
        const float4 b0 = *(const float4*)(B + (size_t)(k0 + bk) * ldb + n0 + bc), b1 = *(const float4*)(B + (size_t)(k0 + bk) * ldb + n0 + bc + 4);
        __syncthreads();
        As[ak + 0][ar] = a0.x; As[ak + 1][ar] = a0.y; As[ak + 2][ar] = a0.z; As[ak + 3][ar] = a0.w;
        As[ak + 4][ar] = a1.x; As[ak + 5][ar] = a1.y; As[ak + 6][ar] = a1.z; As[ak + 7][ar] = a1.w;
        *(float4*)&Bs[bk][bc] = b0; *(float4*)&Bs[bk][bc + 4] = b1;
        __syncthreads();
#pragma unroll
        for (int k = 0; k < 16; ++k) {
            const float4 x0 = *(const float4*)&As[k][ty * 8], x1 = *(const float4*)&As[k][ty * 8 + 4];
            const float4 y0 = *(const float4*)&Bs[k][tx * 8], y1 = *(const float4*)&Bs[k][tx * 8 + 4];
            const float a[8] = {x0.x, x0.y, x0.z, x0.w, x1.x, x1.y, x1.z, x1.w}, b[8] = {y0.x, y0.y, y0.z, y0.w, y1.x, y1.y, y1.z, y1.w};
#pragma unroll
            for (int i = 0; i < 8; ++i)
#pragma unroll
                for (int j = 0; j < 8; ++j) acc[i][j] += a[i] * b[j];
        }
    }
#pragma unroll
    for (int i = 0; i < 8; ++i) {
        float* cp = C + (size_t)(m0 + ty * 8 + i) * ldc + n0 + tx * 8;
#pragma unroll
        for (int j = 0; j < 8; ++j) { float v = acc[i][j]; if (MODE == 1) { v = v > 0.f ? v * v : 0.f; } if (MODE == 2) v += cp[j]; cp[j] = v; }
    }
}

__global__ void __launch_bounds__(64) k_s5(const float* PROJ, const float* a_re, const float* a_im, const float* b_re, const float* b_im, const float* c_re, const float* c_im,
                                           const float* dd, const float* log_step, const float* x0r, const float* x0i, float* Y, float* o_rp, float* o_ip, float* o_rs, float* o_is) {
    const int blk = blockIdx.x, p = threadIdx.x; const bool prompt = blk < 256;
    const int b = prompt ? blk >> 6 : (blk - 256) >> 6, g = blk & 63, T = prompt ? 2048 : 4; const int tok0 = prompt ? b * 2048 : NPROMPT + b * 4;
    const float dt = expf(log_step[g]), are = a_re[g * 64 + p], aim = a_im[g * 64 + p];
    const float mag = expf(are * dt), lr = mag * cosf(aim * dt), li = mag * sinf(aim * dt);
    const float den = are * are + aim * aim, nr = lr - 1.f, ni = li, rr = (nr * are + ni * aim) / den, ri = (ni * are - nr * aim) / den;
    float bbr[16], bbi[16], cr[16], ci[16];
#pragma unroll
    for (int c = 0; c < 16; ++c) { const float br = b_re[(g * 64 + p) * 16 + c], bi = b_im[(g * 64 + p) * 16 + c]; bbr[c] = rr * br - ri * bi; bbi[c] = rr * bi + ri * br;
        cr[c] = c_re[(g * 16 + c) * 64 + p]; ci[c] = c_im[(g * 16 + c) * 64 + p]; }
    float xr = prompt ? 0.f : x0r[(b * 64 + g) * 64 + p], xi = prompt ? 0.f : x0i[(b * 64 + g) * 64 + p];
    for (int t = 0; t < T; ++t) {
        const float* up = PROJ + (size_t)(tok0 + t) * 5120 + 4096 + g * 16;
        float u[16];
#pragma unroll
        for (int c = 0; c < 16; ++c) u[c] = up[c];
        float br = 0.f, bi = 0.f;
#pragma unroll
        for (int c = 0; c < 16; ++c) { br += bbr[c] * u[c]; bi += bbi[c] * u[c]; }
        const float nxr = lr * xr - li * xi + br, nxi = lr * xi + li * xr + bi; xr = nxr; xi = nxi;
        float myy = 0.f;
#pragma unroll
        for (int c = 0; c < 16; ++c) { float v = cr[c] * xr - ci[c] * xi;
#pragma unroll
            for (int o = 1; o < 64; o <<= 1) v += __shfl_xor(v, o);
            if (p == c) myy = v; }
        if (p < 16) { float y = myy + dd[g * 16 + p] * u[p]; Y[(size_t)(tok0 + t) * 1024 + g * 16 + p] = gelu_t(y); }
    }
    if (prompt) { o_rp[(b * 64 + g) * 64 + p] = xr; o_ip[(b * 64 + g) * 64 + p] = xi; } else { o_rs[(b * 64 + g) * 64 + p] = xr; o_is[(b * 64 + g) * 64 + p] = xi; }
}

__global__ void __launch_bounds__(256) k_glu(const float* Y, const float* Z, const float* gb, float* MIXIN) {
    const size_t i = (size_t)blockIdx.x * 256 + threadIdx.x; if (i >= (size_t)NTOK * 1024) return; const int r = (int)(i >> 10), c = (int)(i & 1023);
    MIXIN[(size_t)r * 2048 + 1024 + c] = Y[i] * sigm(Z[i] + gb[c]);
}

__global__ void __launch_bounds__(512) k_hgrn(const float* PROJ, const float* lbl, const float* s0, float* ORAW, float* o_sp, float* o_ss) {
    __shared__ float red[16][128]; __shared__ float fq[3][128];
    const int blk = blockIdx.x, tid = threadIdx.x; const bool prompt = blk < 32; const int bh = prompt ? blk : blk - 32, b = bh >> 3, h = bh & 7, T = prompt ? 2048 : 4;
    const int tok0 = prompt ? b * 2048 : NPROMPT + b * 4; const int v4 = tid & 31, kr = tid >> 5;
    float4 S[8];
#pragma unroll
    for (int i = 0; i < 8; ++i) S[i] = prompt ? make_float4(0.f, 0.f, 0.f, 0.f) : *(const float4*)(s0 + ((size_t)bh * 128 + kr + 16 * i) * 128 + 4 * v4);
    for (int t = 0; t < T; ++t) {
        const float* pr = PROJ + (size_t)(tok0 + t) * 5120;
        if (tid < 128) { const int col = h * 128 + tid; const float e0 = expf(lbl[col]), e1 = expf(lbl[1024 + col]), lb = e0 / (e0 + e1);
            const float f = lb + (1.f - lb) * sigm(pr[1024 + col]); fq[0][tid] = f; fq[1][tid] = 1.f - f; fq[2][tid] = silu(pr[col]); }
        __syncthreads();
        const float4 vv = *(const float4*)(pr + 2048 + h * 128 + 4 * v4);
        float4 po = make_float4(0.f, 0.f, 0.f, 0.f);
#pragma unroll
        for (int i = 0; i < 8; ++i) { const int k = kr + 16 * i; const float f = fq[0][k], kk = fq[1][k], q = fq[2][k];
            S[i].x = f * S[i].x + kk * vv.x; S[i].y = f * S[i].y + kk * vv.y; S[i].z = f * S[i].z + kk * vv.z; S[i].w = f * S[i].w + kk * vv.w;
            po.x += S[i].x * q; po.y += S[i].y * q; po.z += S[i].z * q; po.w += S[i].w * q; }
        *(float4*)&red[kr][4 * v4] = po;
        __syncthreads();
        if (tid < 128) { float s = 0.f;
#pragma unroll
            for (int j = 0; j < 16; ++j) s += red[j][tid];
            ORAW[(size_t)(tok0 + t) * 1024 + h * 128 + tid] = s; }
    }
    float* os = prompt ? o_sp : o_ss;
#pragma unroll
    for (int i = 0; i < 8; ++i) *(float4*)(os + ((size_t)bh * 128 + kr + 16 * i) * 128 + 4 * v4) = S[i];
}

__global__ void __launch_bounds__(256) k_gate(const float* ORAW, const float* PROJ, const float* ng, float* MIXIN) {
    const int r = blockIdx.x; __shared__ float red[256];
    float s = 0.f; for (int i = threadIdx.x; i < 1024; i += 256) { float v = ORAW[(size_t)r * 1024 + i]; s += v * v; }
    red[threadIdx.x] = s; __syncthreads();
    for (int o = 128; o > 0; o >>= 1) { if ((int)threadIdx.x < o) red[threadIdx.x] += red[threadIdx.x + o]; __syncthreads(); }
    const float rstd = rsqrtf(red[0] / 1024.f + 1e-6f);
    for (int i = threadIdx.x; i < 1024; i += 256) MIXIN[(size_t)r * 2048 + i] = ORAW[(size_t)r * 1024 + i] * rstd * ng[i] * silu(PROJ[(size_t)r * 5120 + 3072 + i]);
}

static void run_naive(void* const* d_in, float* out, unsigned char* ws, hipStream_t st) {
    const float* xp = (const float*)d_in[0]; const float* xs = (const float*)d_in[1];
    float* H = (float*)ws;
    float* PROJ = (float*)(ws + (size_t)72 * 1048576);
    float* MIXIN = (float*)(ws + (size_t)244 * 1048576);
    float* Y = H; float* ORAW = H + (size_t)NTOK * 1024;
    float* o_yp = out; float* o_hp = out + 17825792; float* o_rp = out + 18350080; float* o_ip = out + 18366464;
    float* o_hs = out + 18382848; float* o_rs = out + 35160064; float* o_is = out + 35684352;
    float* Z = o_hs;
    k_rms<<<NTOK, 256, 0, st>>>(xp, xs, (const float*)d_in[7], H, DM);
    sgemm<0><<<dim3(5120 / 128, NTOK / 128), 256, 0, st>>>(H, (const float*)d_in[5], PROJ, 2048, 2048, 5120, 5120);
    k_s5<<<256 + 8192, 64, 0, st>>>(PROJ, (const float*)d_in[11], (const float*)d_in[12], (const float*)d_in[13], (const float*)d_in[14], (const float*)d_in[15], (const float*)d_in[16],
                                    (const float*)d_in[17], (const float*)d_in[18], (const float*)d_in[3], (const float*)d_in[4], Y, o_rp, o_ip, o_rs, o_is);
    sgemm<0><<<dim3(1024 / 128, NTOK / 128), 256, 0, st>>>(Y, (const float*)d_in[19], Z, 1024, 1024, 1024, 1024);
    k_glu<<<(NTOK * 1024) / 256, 256, 0, st>>>(Y, Z, (const float*)d_in[20], MIXIN);
    k_hgrn<<<32 + 1024, 512, 0, st>>>(PROJ, (const float*)d_in[9], (const float*)d_in[2], ORAW, o_hp, o_hs);
    k_gate<<<NTOK, 256, 0, st>>>(ORAW, PROJ, (const float*)d_in[10], MIXIN);
    hipMemcpyAsync(o_yp, xp, (size_t)NPROMPT * DM * 4, hipMemcpyDeviceToDevice, st);
    hipMemcpyAsync(o_yp + (size_t)NPROMPT * DM, xs, (size_t)512 * DM * 4, hipMemcpyDeviceToDevice, st);
    sgemm<2><<<dim3(2048 / 128, NTOK / 128), 256, 0, st>>>(MIXIN, (const float*)d_in[6], o_yp, 2048, 2048, 2048, 2048);
    float* H2 = H; float* FF1 = PROJ;
    k_rms<<<NTOK, 256, 0, st>>>(o_yp, o_yp + (size_t)NPROMPT * DM, (const float*)d_in[8], H2, DM);
    for (int rb = 0; rb < 4; ++rb) {
        sgemm<1><<<dim3(8192 / 128, 2176 / 128), 256, 0, st>>>(H2 + (size_t)rb * 2176 * DM, (const float*)d_in[21], FF1, 2048, 2048, 8192, 8192);
        sgemm<2><<<dim3(2048 / 128, 2176 / 128), 256, 0, st>>>(FF1, (const float*)d_in[22], o_yp + (size_t)rb * 2176 * DM, 8192, 8192, 2048, 2048);
    }
    k_rms<<<NTOK, 256, 0, st>>>(o_yp, o_yp + (size_t)NPROMPT * DM, (const float*)d_in[23], o_yp, DM);
}
}
extern "C" void kernel_launch(void* const* d_in, const int* in_sizes, int n_in, void* d_out, int out_size, void* d_ws, size_t ws_size, hipStream_t stream) {
    if (ws_size < (size_t)313 * 1048576) { fprintf(stderr, "ws too small: %zu\n", ws_size); return; }
    nv::run_naive(d_in, (float*)d_out, (unsigned char*)d_ws, stream);
}
```

```cpp
#include <hip/hip_runtime.h>
#include <hip/hip_cooperative_groups.h>
#include <cstdio>
#include <cstdint>
namespace cg = cooperative_groups;

#define LAS __attribute__((address_space(3)))
typedef unsigned short bf16_t;
typedef short bf16x8 __attribute__((ext_vector_type(8)));
typedef float f32x4 __attribute__((ext_vector_type(4)));
typedef float f32x2 __attribute__((ext_vector_type(2)));
typedef unsigned u32x4 __attribute__((ext_vector_type(4)));
typedef unsigned u32x2 __attribute__((ext_vector_type(2)));

__device__ __forceinline__ unsigned cvt_pk_bf16(float lo, float hi) { unsigned r; asm volatile("v_cvt_pk_bf16_f32 %0, %1, %2" : "=v"(r) : "v"(lo), "v"(hi)); return r; }
__device__ __forceinline__ float bf_lo(unsigned w) { return __uint_as_float(w << 16); }
__device__ __forceinline__ float bf_hi(unsigned w) { return __uint_as_float(w & 0xffff0000u); }
__device__ __forceinline__ float bf2f(bf16_t v) { return __uint_as_float(((unsigned)v) << 16); }
__device__ __forceinline__ bf16_t f2bf(float f) { return (bf16_t)(cvt_pk_bf16(f, 0.f) & 0xffffu); }
__device__ __forceinline__ float sigm_f(float v) { return __builtin_amdgcn_rcpf(1.f + __expf(-v)); }
__device__ __forceinline__ float silu_f(float v) { return v * __builtin_amdgcn_rcpf(1.f + __expf(-v)); }
__device__ __forceinline__ float gelu_tanh_f(float v) { const float u = 1.5957691216057308f * (v + 0.044715f * v * v * v); return v * __builtin_amdgcn_rcpf(1.f + __expf(-u)); }
__device__ __forceinline__ float wave_sum(float v) {
#pragma unroll
    for (int o = 1; o < 64; o <<= 1) v += __shfl_xor(v, o);
    return v;
}
#define LDS_WAIT() asm volatile("s_waitcnt lgkmcnt(0)" ::: "memory")

constexpr int NTOK = 8704, NPROMPT = 8192, DM = 2048, DFF = 8192, INC = 5120, WA = 1024;
constexpr size_t MiB = 1048576;
constexpr size_t WS_UG = 0, WS_XLOC = 20 * MiB, WS_US = 28 * MiB, WS_WTDOWN = 0;
constexpr size_t WS_HB = 32 * MiB, WS_YBUF = 32 * MiB, WS_QB = 66 * MiB, WS_VB = 83 * MiB, WS_GB = 100 * MiB, WS_LF = 117 * MiB, WS_WTGLU = 151 * MiB, WS_WTOUT = 153 * MiB, WS_H = 32 * MiB;
constexpr size_t WS_WTIN = 168 * MiB, WS_PRE = 168 * MiB, WS_WTUP = 168 * MiB, WS_A2 = 200 * MiB, WS_TB = 234 * MiB, WS_MIX = 234 * MiB, WS_GT = 274 * MiB, WS_PART = 168 * MiB;
constexpr size_t WS_MISC = 304 * MiB, WS_SS2 = WS_MISC, WS_LB = WS_MISC + 65536, WS_LAMT = WS_MISC + 131072, WS_BBT = WS_MISC + 262144, WS_DL = WS_MISC + MiB, WS_ORAWS = WS_MISC + 2 * MiB, WS_END = 308 * MiB;
constexpr size_t O_YP = 0, O_HP = 17825792, O_RP = 18350080, O_IP = 18366464, O_HS = 18382848, O_RS = 35160064, O_IS = 35684352;
namespace pg8 {
#define PG8_LAS __attribute__((address_space(3)))
constexpr int BM = 256, BK = 64, HALF = 128, HTB = HALF * BK * 2  , STAGE_BYTES = 8 * HTB, NXCD = 8, WGM = 8;
__host__ __device__ __forceinline__ int lds_byte(int r, int c) { const int st = (r >> 4) * 2 + (c >> 5), rr = r & 15, cc = c & 31, ob = rr * 64 + cc * 2; return st * 1024 + (ob ^ (((ob >> 9) & 1) << 5)); }
__host__ __device__ __forceinline__ void stage_rc(int b, int& R, int& C) { const int st = b / 1024, sb = b % 1024, swz = sb ^ (((sb >> 9) & 1) << 5); R = (st >> 1) * 16 + swz / 64; C = (st & 1) * 32 + (swz % 64) / 2; }
__host__ __device__ __forceinline__ int perm32(int rho) { const int n = rho >> 4, i = rho & 15; return 8 * (i >> 2) + 4 * n + (i & 3); }
struct Unit { int pm, pn, z; };
struct Gemm { const bf16_t* A; const bf16_t* Bt; int K, lda, ldb; };

struct TileOrder {
    int nM, nN, nwg, nZ, G, c;
    __device__ __forceinline__ void init(int M, int N, int nZ_, int G_, int c_) { nM = M / BM; nN = N / BM; nwg = nM * nN; nZ = nZ_; G = G_; c = c_; }
    __device__ __forceinline__ bool next(int i, Unit& u) const {
        const long L = (long)i * G + c; if (L >= (long)nwg * nZ) return false;
        u.z = (int)(L / nwg); int wgid = (int)(L % nwg); { const int q = nwg / NXCD, r = nwg % NXCD, xcd = wgid % NXCD, off = wgid / NXCD; wgid = (xcd < r ? xcd * (q + 1) : r * (q + 1) + (xcd - r) * q) + off; }
        const int nig = WGM * nN, gid = wgid / nig, fm = gid * WGM, gsz = (nM - fm) < WGM ? (nM - fm) : WGM;
        u.pm = fm + ((wgid % nig) % gsz); u.pn = (wgid % nig) / gsz; return true;
    }
    __device__ __forceinline__ const char* a_base(const Gemm& g, const Unit& u) const { return (const char*)(g.A + (size_t)u.pm * BM * g.lda + (size_t)u.z * g.K); }
    __device__ __forceinline__ const char* b_base(const Gemm& g, const Unit& u) const { return (const char*)(g.Bt + (size_t)u.pn * BM * g.ldb + (size_t)u.z * g.K); }
    __device__ __forceinline__ void a_ready(const Unit&) const {}
    __device__ __forceinline__ void done(const Unit&) const {}
};
struct GroupOrder {
    int g0, ng, npn, G, c; size_t a_gstride, b_gstride;
    __device__ __forceinline__ bool next(int i, Unit& u) const { const int per = i / npn, gi = per * G + c; if (gi >= ng) return false; u.pm = 0; u.pn = i % npn; u.z = g0 + gi; return true; }
    __device__ __forceinline__ const char* a_base(const Gemm& g, const Unit& u) const { return (const char*)(g.A + (size_t)u.z * a_gstride); }
    __device__ __forceinline__ const char* b_base(const Gemm& g, const Unit& u) const { return (const char*)(g.Bt + (size_t)u.z * b_gstride + (size_t)u.pn * BM * g.ldb); }
    __device__ __forceinline__ void a_ready(const Unit&) const {}
    __device__ __forceinline__ void done(const Unit&) const {}
};
template <class Epi, class Sched, bool ALIGN_EPI = false, bool SP2 = false>
__device__ __forceinline__ void gemm_phase(PG8_LAS unsigned char* lds, const Gemm g, const Sched& S, const Epi& E) {
    const int tid = threadIdx.x, wid = __builtin_amdgcn_readfirstlane(tid >> 6), lane = tid & 63, wr = wid >> 2, wc = wid & 3, fr = lane & 15, fq = lane >> 4;
    const int K = g.K, nt = K / BK, lda = g.lda, ldb = g.ldb;
    unsigned voffA[2], voffB[2];
#pragma unroll
    for (int i = 0; i < 2; ++i) { int R, C; stage_rc(tid * 16 + i * 8192, R, C); const int Rb = Epi::PERM ? ((R & ~31) + perm32(R & 31)) : R;
        voffA[i] = (unsigned)(R * lda + C) * 2u; voffB[i] = (unsigned)(Rb * ldb + C) * 2u; }
    const size_t kstep = (size_t)(BK * 2);
    const size_t hstepA = (size_t)HALF * lda * 2, hstepB = (size_t)HALF * ldb * 2;
    const unsigned ldsw = (unsigned)wid * 1024u;
    const int aoff = lds_byte(wr * 64 + fr, fq * 8), boff = lds_byte(wc * 32 + fr, fq * 8);
#define PG8_SA(b, h) (((b) * 2 + (h)) * HTB)
#define PG8_SB(b, h) ((4 + (b) * 2 + (h)) * HTB)
#define PG8_STAGE(bufoff, gbase, voff) do { _Pragma("unroll") for (int _i = 0; _i < 2; ++_i) \
        __builtin_amdgcn_global_load_lds((const unsigned*)((const char*)(gbase) + (voff)[_i]), (PG8_LAS unsigned*)(lds + (bufoff) + ldsw + _i * 8192), 16, 0, 0); } while (0)
#define PG8_LDA(dst, b, h) do { _Pragma("unroll") for (int m = 0; m < 4; ++m) _Pragma("unroll") for (int k = 0; k < 2; ++k) dst[m][k] = *(const PG8_LAS bf16x8*)(lds + PG8_SA(b, h) + aoff + m * 2048 + k * 1024); } while (0)
#define PG8_LDB(dst, b, h) do { _Pragma("unroll") for (int n = 0; n < 2; ++n) _Pragma("unroll") for (int k = 0; k < 2; ++k) dst[n][k] = *(const PG8_LAS bf16x8*)(lds + PG8_SB(b, h) + boff + n * 2048 + k * 1024); } while (0)
#define PG8_MMA(ai, bj, At, Bt) do { __builtin_amdgcn_s_setprio(1); _Pragma("unroll") for (int m = 0; m < 4; ++m) _Pragma("unroll") for (int n = 0; n < 2; ++n) _Pragma("unroll") for (int k = 0; k < 2; ++k) \
        acc[ai][bj][m][n] = __builtin_amdgcn_mfma_f32_16x16x32_bf16(Bt[n][k], At[m][k], acc[ai][bj][m][n], 0, 0, 0); __builtin_amdgcn_s_setprio(0); } while (0)
#define PG8_WAIT_V(n) asm volatile("s_waitcnt vmcnt(" #n ")" ::: "memory")
#define PG8_WAIT_L(n) asm volatile("s_waitcnt lgkmcnt(" #n ")" ::: "memory")
#define PG8_BAR __builtin_amdgcn_s_barrier()
#define PG8_SCHED __builtin_amdgcn_sched_barrier(0)
    Unit cur, nxt; int ui = 0;
    if (!S.next(0, cur)) return;
    f32x4 acc[2][2][4][2];
#pragma unroll
    for (int a = 0; a < 2; ++a)
#pragma unroll
        for (int b = 0; b < 2; ++b)
#pragma unroll
            for (int m = 0; m < 4; ++m)
#pragma unroll
                for (int n = 0; n < 2; ++n) acc[a][b][m][n] = (f32x4){0.f, 0.f, 0.f, 0.f};
    bf16x8 At[4][2], B0[2][2], B1[2][2];
    const char* cA = S.a_base(g, cur); const char* cB = S.b_base(g, cur);
    S.a_ready(cur);
    if constexpr (SP2) {
        PG8_STAGE(PG8_SB(0, 0), cB, voffB); PG8_STAGE(PG8_SB(0, 1), cB + hstepB, voffB); PG8_STAGE(PG8_SA(0, 0), cA, voffA); PG8_STAGE(PG8_SA(0, 1), cA + hstepA, voffA);
        if (wr == 1) PG8_BAR;
        PG8_WAIT_V(2); PG8_BAR;
        PG8_STAGE(PG8_SB(1, 0), cB + kstep, voffB); PG8_STAGE(PG8_SA(1, 0), cA + kstep, voffA); PG8_STAGE(PG8_SB(1, 1), cB + hstepB + kstep, voffB);
        PG8_WAIT_V(6); PG8_BAR;
    } else {
        PG8_STAGE(PG8_SB(0, 0), cB, voffB); PG8_STAGE(PG8_SA(0, 0), cA, voffA); PG8_STAGE(PG8_SB(0, 1), cB + hstepB, voffB); PG8_STAGE(PG8_SA(0, 1), cA + hstepA, voffA);
        if (wr == 1) PG8_BAR;
        PG8_WAIT_V(4); PG8_BAR;
        PG8_STAGE(PG8_SB(1, 0), cB + kstep, voffB); PG8_STAGE(PG8_SA(1, 0), cA + kstep, voffA); PG8_STAGE(PG8_SB(1, 1), cB + hstepB + kstep, voffB);
        PG8_WAIT_V(6); PG8_BAR;
    }
    for (;;) {
        const bool has_next = S.next(ui + 1, nxt);
        const char* nA = has_next ? S.a_base(g, nxt) : cA; const char* nB = has_next ? S.b_base(g, nxt) : cB;
        for (int t = 0; t < nt; t += 2) {
            const bool last = (t == nt - 2);
            const char* a1 = cA + (size_t)(t + 1) * kstep;
            const char* a2 = last ? nA : cA + (size_t)(t + 2) * kstep; const char* b2 = last ? nB : cB + (size_t)(t + 2) * kstep;
            const char* a3 = a2 + kstep; const char* b3 = b2 + kstep;
            if (last && has_next) S.a_ready(nxt);
            if constexpr (SP2) {
            PG8_LDB(B0, 0, 0); PG8_LDB(B1, 0, 1); PG8_SCHED; PG8_LDA(At, 0, 0); PG8_STAGE(PG8_SA(1, 1), a1 + hstepA, voffA);
            PG8_WAIT_V(8); PG8_WAIT_L(0); PG8_BAR; PG8_MMA(0, 0, At, B0); PG8_MMA(0, 1, At, B1); PG8_BAR; PG8_SCHED;
            PG8_LDA(At, 0, 1); PG8_STAGE(PG8_SB(0, 0), b2, voffB); PG8_STAGE(PG8_SB(0, 1), b2 + hstepB, voffB); PG8_STAGE(PG8_SA(0, 0), a2, voffA);
            PG8_WAIT_V(8); PG8_WAIT_L(0); PG8_BAR; PG8_MMA(1, 0, At, B0); PG8_MMA(1, 1, At, B1); PG8_BAR; PG8_SCHED;
            PG8_LDB(B0, 1, 0); PG8_LDB(B1, 1, 1); PG8_SCHED; PG8_LDA(At, 1, 0); PG8_STAGE(PG8_SA(0, 1), a2 + hstepA, voffA);
            PG8_WAIT_V(8); PG8_WAIT_L(0); PG8_BAR; PG8_MMA(0, 0, At, B0); PG8_MMA(0, 1, At, B1); PG8_BAR; PG8_SCHED;
            PG8_LDA(At, 1, 1); PG8_STAGE(PG8_SB(1, 0), b3, voffB); PG8_STAGE(PG8_SB(1, 1), b3 + hstepB, voffB); PG8_STAGE(PG8_SA(1, 0), a3, voffA);
            PG8_WAIT_V(8); PG8_WAIT_L(0); PG8_BAR; PG8_MMA(1, 0, At, B0); PG8_MMA(1, 1, At, B1); PG8_BAR; PG8_SCHED;
            } else {
            PG8_LDB(B0, 0, 0); PG8_SCHED; PG8_LDA(At, 0, 0); PG8_STAGE(PG8_SA(1, 1), a1 + hstepA, voffA);
            PG8_WAIT_L(8); PG8_BAR; PG8_WAIT_L(0); PG8_MMA(0, 0, At, B0); PG8_BAR; PG8_SCHED;
            PG8_LDB(B1, 0, 1); PG8_STAGE(PG8_SB(0, 0), b2, voffB);
            PG8_BAR; PG8_WAIT_L(0); PG8_MMA(0, 1, At, B1); PG8_BAR;
            PG8_LDA(At, 0, 1); PG8_STAGE(PG8_SA(0, 0), a2, voffA);
            PG8_BAR; PG8_WAIT_L(0); PG8_MMA(1, 0, At, B0); PG8_BAR; PG8_SCHED;
            PG8_STAGE(PG8_SB(0, 1), b2 + hstepB, voffB);
            PG8_WAIT_V(6); PG8_BAR; PG8_MMA(1, 1, At, B1); PG8_BAR;
            PG8_LDB(B0, 1, 0); PG8_SCHED; PG8_LDA(At, 1, 0); PG8_STAGE(PG8_SA(0, 1), a2 + hstepA, voffA);
            PG8_WAIT_L(8); PG8_BAR; PG8_WAIT_L(0); PG8_MMA(0, 0, At, B0); PG8_BAR; PG8_SCHED;
            PG8_LDB(B1, 1, 1); PG8_STAGE(PG8_SB(1, 0), b3, voffB);
            PG8_BAR; PG8_WAIT_L(0); PG8_MMA(0, 1, At, B1); PG8_BAR;
            PG8_LDA(At, 1, 1); PG8_STAGE(PG8_SA(1, 0), a3, voffA);
            PG8_BAR; PG8_WAIT_L(0); PG8_MMA(1, 0, At, B0); PG8_BAR; PG8_SCHED;
            PG8_STAGE(PG8_SB(1, 1), b3 + hstepB, voffB);
            PG8_WAIT_V(6); PG8_BAR; PG8_MMA(1, 1, At, B1); PG8_BAR;
            }
        }
        if constexpr (ALIGN_EPI) { if (wr == 0) PG8_BAR; }
        if constexpr (!Epi::AFTER_DRAIN) { E(acc, cur, wr, wc, fr, fq); S.done(cur); }
        if (!has_next) break;
#pragma unroll
        for (int a = 0; a < 2; ++a)
#pragma unroll
            for (int b = 0; b < 2; ++b)
#pragma unroll
                for (int m = 0; m < 4; ++m)
#pragma unroll
                    for (int n = 0; n < 2; ++n) acc[a][b][m][n] = (f32x4){0.f, 0.f, 0.f, 0.f};
        cur = nxt; cA = nA; cB = nB; ++ui;
        if constexpr (ALIGN_EPI) { if (wr == 1) PG8_BAR; }
    }
    PG8_WAIT_V(0);
    if constexpr (!ALIGN_EPI) { if (wr == 0) PG8_BAR; }
    PG8_BAR;
    if constexpr (Epi::AFTER_DRAIN) { E.fused(acc, cur, wr, wc, fr, fq, lds, wid, lane); S.done(cur); }
#undef PG8_SA
#undef PG8_SB
#undef PG8_STAGE
#undef PG8_LDA
#undef PG8_LDB
#undef PG8_MMA
#undef PG8_WAIT_V
#undef PG8_WAIT_L
#undef PG8_BAR
#undef PG8_SCHED
}
}
namespace pg8 {
#define EPI_FOR_ROWS _Pragma("unroll") for (int ai = 0; ai < 2; ++ai) _Pragma("unroll") for (int m = 0; m < 4; ++m)
#define EPI_ROW (u.pm * BM + ai * HALF + wr * 64 + m * 16 + fr)
#define EPI_PK8(v0, v1) ((u32x4){cvt_pk_bf16((v0)[0], (v0)[1]), cvt_pk_bf16((v0)[2], (v0)[3]), cvt_pk_bf16((v1)[0], (v1)[1]), cvt_pk_bf16((v1)[2], (v1)[3])})

struct Epi1 {
    static constexpr bool PERM = true, AFTER_DRAIN = false;
    unsigned char* ws; const float* LB;
    __device__ __forceinline__ void operator()(const f32x4 (&acc)[2][2][4][2], const Unit& u, int wr, int wc, int fr, int fq) const {
        const int kind = u.pn >> 2, colt = (u.pn & 3) * BM + wc * 32 + 8 * fq;
        if (kind == 1) {
            f32x4 lb0[2], lb1[2];
#pragma unroll
            for (int bj = 0; bj < 2; ++bj) { lb0[bj] = *(const f32x4*)(LB + colt + bj * HALF); lb1[bj] = *(const f32x4*)(LB + colt + bj * HALF + 4); }
            EPI_FOR_ROWS { const int row = EPI_ROW;
#pragma unroll
                for (int bj = 0; bj < 2; ++bj) { f32x4 v0 = acc[ai][bj][m][0], v1 = acc[ai][bj][m][1];
#pragma unroll
                    for (int j = 0; j < 4; ++j) { v0[j] = __logf(lb0[bj][j] + (1.f - lb0[bj][j]) * sigm_f(v0[j])); v1[j] = __logf(lb1[bj][j] + (1.f - lb1[bj][j]) * sigm_f(v1[j])); }
                    float* p = (float*)(ws + WS_LF) + (size_t)row * WA + colt + bj * HALF; *(f32x4*)p = v0; *(f32x4*)(p + 4) = v1; } }
        } else if (kind == 4) {
            EPI_FOR_ROWS { const int row = EPI_ROW;
#pragma unroll
                for (int bj = 0; bj < 2; ++bj) { const int col = colt + bj * HALF; const u32x4 w = EPI_PK8(acc[ai][bj][m][0], acc[ai][bj][m][1]);
                    if (row < NPROMPT) *(u32x4*)((bf16_t*)(ws + WS_UG) + ((size_t)((col >> 4) * 256 + (row >> 5)) * 640 + (row & 31) * 16 + (col & 15))) = w;
                    else *(u32x4*)((bf16_t*)(ws + WS_US) + (size_t)(row - NPROMPT) * WA + col) = w; } }
        } else {
            const size_t ooff = kind == 0 ? WS_QB : (kind == 2 ? WS_VB : WS_GB); bf16_t* O = (bf16_t*)(ws + ooff);
            EPI_FOR_ROWS { const int row = EPI_ROW;
#pragma unroll
                for (int bj = 0; bj < 2; ++bj) { f32x4 v0 = acc[ai][bj][m][0], v1 = acc[ai][bj][m][1];
                    if (kind != 2) {
#pragma unroll
                        for (int j = 0; j < 4; ++j) { v0[j] = silu_f(v0[j]); v1[j] = silu_f(v1[j]); } }
                    *(u32x4*)(O + (size_t)row * WA + colt + bj * HALF) = EPI_PK8(v0, v1); } }
        }
    }
};
struct EpiS1 {
    static constexpr bool PERM = false, AFTER_DRAIN = false;
    float* XLOC;
    __device__ __forceinline__ void operator()(const f32x4 (&acc)[2][2][4][2], const Unit& u, int wr, int wc, int fr, int fq) const {
        EPI_FOR_ROWS { const int row = EPI_ROW;
#pragma unroll
            for (int n = 0; n < 2; ++n) *(f32x4*)(XLOC + ((size_t)u.z * 256 + row) * 128 + wc * 32 + n * 16 + 4 * fq) = acc[ai][0][m][n]; }
    }
};
struct EpiS2 {
    static constexpr bool PERM = true, AFTER_DRAIN = false;
    bf16_t* YBUF;
    __device__ __forceinline__ void operator()(const f32x4 (&acc)[2][2][4][2], const Unit& u, int wr, int wc, int fr, int fq) const {
        EPI_FOR_ROWS { const int row = EPI_ROW;
#pragma unroll
            for (int bj = 0; bj < 2; ++bj) { const int n8 = u.pn * BM + bj * HALF + wc * 32 + 8 * fq; f32x4 v0 = acc[ai][bj][m][0], v1 = acc[ai][bj][m][1];
#pragma unroll
                for (int j = 0; j < 4; ++j) { v0[j] = gelu_tanh_f(v0[j]); v1[j] = gelu_tanh_f(v1[j]); }
                *(u32x4*)(YBUF + ((size_t)row * 32 + (n8 >> 4)) * WA + u.z * 16 + (n8 & 15)) = EPI_PK8(v0, v1); } }
    }
};
struct EpiGlu {
    static constexpr bool PERM = true, AFTER_DRAIN = false;
    const bf16_t* YBUF; const float* gb; bf16_t* MIX;
    __device__ __forceinline__ void operator()(const f32x4 (&acc)[2][2][4][2], const Unit& u, int wr, int wc, int fr, int fq) const {
        const int colt = u.pn * BM + wc * 32 + 8 * fq;
        f32x4 b0[2], b1[2];
#pragma unroll
        for (int bj = 0; bj < 2; ++bj) { b0[bj] = *(const f32x4*)(gb + colt + bj * HALF); b1[bj] = *(const f32x4*)(gb + colt + bj * HALF + 4); }
        EPI_FOR_ROWS { const int row = EPI_ROW;
#pragma unroll
            for (int bj = 0; bj < 2; ++bj) { const int col = colt + bj * HALF; const u32x4 yw = *(const u32x4*)(YBUF + (size_t)row * WA + col);
                const f32x4 z0 = acc[ai][bj][m][0] + b0[bj], z1 = acc[ai][bj][m][1] + b1[bj]; f32x4 v0, v1;
                v0[0] = bf_lo(yw[0]) * sigm_f(z0[0]); v0[1] = bf_hi(yw[0]) * sigm_f(z0[1]); v0[2] = bf_lo(yw[1]) * sigm_f(z0[2]); v0[3] = bf_hi(yw[1]) * sigm_f(z0[3]);
                v1[0] = bf_lo(yw[2]) * sigm_f(z1[0]); v1[1] = bf_hi(yw[2]) * sigm_f(z1[1]); v1[2] = bf_lo(yw[3]) * sigm_f(z1[2]); v1[3] = bf_hi(yw[3]) * sigm_f(z1[3]);
                *(u32x4*)(MIX + (size_t)row * DM + WA + col) = EPI_PK8(v0, v1); } }
    }
};
struct EpiOut {
    static constexpr bool PERM = true, AFTER_DRAIN = false;
    const float *xp, *xs; float* X1; bf16_t* A2; float* SS2;
    __device__ __forceinline__ void operator()(const f32x4 (&acc)[2][2][4][2], const Unit& u, int wr, int wc, int fr, int fq) const {
        const int colt = u.pn * BM + wc * 32 + 8 * fq;
        EPI_FOR_ROWS { const int row = EPI_ROW;
            const float* xr = row < NPROMPT ? xp + (size_t)row * DM : xs + (size_t)(row - NPROMPT) * DM; float ss = 0.f;
#pragma unroll
            for (int bj = 0; bj < 2; ++bj) { const int col = colt + bj * HALF; const f32x4 v0 = acc[ai][bj][m][0] + *(const f32x4*)(xr + col), v1 = acc[ai][bj][m][1] + *(const f32x4*)(xr + col + 4);
                *(f32x4*)(X1 + (size_t)row * DM + col) = v0; *(f32x4*)(X1 + (size_t)row * DM + col + 4) = v1;
                *(u32x4*)(A2 + (size_t)row * DM + col) = EPI_PK8(v0, v1);
                ss += (v0[0] * v0[0] + v0[1] * v0[1]) + (v0[2] * v0[2] + v0[3] * v0[3]) + (v1[0] * v1[0] + v1[1] * v1[1]) + (v1[2] * v1[2] + v1[3] * v1[3]); }
            ss += __shfl_xor(ss, 16); ss += __shfl_xor(ss, 32);
            if (fq == 0) atomicAdd(SS2 + row, ss); }
    }
};
struct EpiUp {
    static constexpr bool PERM = true, AFTER_DRAIN = false;
    const float* SS2; bf16_t* H;
    __device__ __forceinline__ void operator()(const f32x4 (&acc)[2][2][4][2], const Unit& u, int wr, int wc, int fr, int fq) const {
        const int colt = u.pn * BM + wc * 32 + 8 * fq;
        EPI_FOR_ROWS { const int row = EPI_ROW;
            const float rs = rsqrtf(SS2[row] * (1.f / DM) + 1e-6f);
#pragma unroll
            for (int bj = 0; bj < 2; ++bj) { f32x4 v0 = acc[ai][bj][m][0] * rs, v1 = acc[ai][bj][m][1] * rs;
#pragma unroll
                for (int j = 0; j < 4; ++j) { const float a = fmaxf(v0[j], 0.f), b = fmaxf(v1[j], 0.f); v0[j] = a * a; v1[j] = b * b; }
                *(u32x4*)(H + (size_t)row * DFF + colt + bj * HALF) = EPI_PK8(v0, v1); } }
    }
};
struct EpiDown {
    static constexpr bool PERM = true, AFTER_DRAIN = false;
    bf16_t* PART;
    __device__ __forceinline__ void operator()(const f32x4 (&acc)[2][2][4][2], const Unit& u, int wr, int wc, int fr, int fq) const {
        const int colt = u.pn * BM + wc * 32 + 8 * fq;
        EPI_FOR_ROWS { const int row = EPI_ROW;
#pragma unroll
            for (int bj = 0; bj < 2; ++bj) *(u32x4*)(PART + ((size_t)u.z * NTOK + row) * DM + colt + bj * HALF) = EPI_PK8(acc[ai][bj][m][0], acc[ai][bj][m][1]); }
    }
};
}
__device__ __forceinline__ void transpose_item(const float* W, int K, int N, bf16_t* WT, LAS float* scr, int item, int lane, const float* kscale) {
    const int nblk = N / 32, kb = item / nblk, nb = item % nblk, k0 = 64 * kb, n0 = 32 * nb;
#pragma unroll 8
    for (int i = 0; i < 32; ++i) { const int kk = 2 * i + (lane >> 5); float v = W[(size_t)(k0 + kk) * N + n0 + (lane & 31)]; if (kscale) v *= kscale[k0 + kk]; scr[kk * 33 + (lane & 31)] = v; }
    LDS_WAIT();
    const int c = lane & 7;
#pragma unroll
    for (int j = 0; j < 4; ++j) { const int n = (lane >> 3) + 8 * j; const LAS float* s = scr + (8 * c) * 33 + n;
        u32x4 o; o.x = cvt_pk_bf16(s[0 * 33], s[1 * 33]); o.y = cvt_pk_bf16(s[2 * 33], s[3 * 33]); o.z = cvt_pk_bf16(s[4 * 33], s[5 * 33]); o.w = cvt_pk_bf16(s[6 * 33], s[7 * 33]);
        *(u32x4*)(WT + (size_t)(n0 + n) * K + k0 + 8 * c) = o; }
    LDS_WAIT();
}
__device__ __forceinline__ void rms_row_bf16(const float* xrow, const float* g, bf16_t* orow, int lane) {
    const f32x4* xr = (const f32x4*)xrow + lane; f32x4 v[8]; float s = 0.f;
#pragma unroll
    for (int j = 0; j < 8; ++j) { v[j] = xr[64 * j]; s += (v[j][0] * v[j][0] + v[j][1] * v[j][1]) + (v[j][2] * v[j][2] + v[j][3] * v[j][3]); }
    const float rstd = rsqrtf(wave_sum(s) * (1.f / DM) + 1e-6f);
    const f32x4* gr = (const f32x4*)g + lane; u32x2* o8 = (u32x2*)orow + lane;
#pragma unroll
    for (int j = 0; j < 8; ++j) { const f32x4 gv = gr[64 * j]; o8[64 * j] = (u32x2){cvt_pk_bf16(v[j][0] * rstd * gv[0], v[j][1] * rstd * gv[1]), cvt_pk_bf16(v[j][2] * rstd * gv[2], v[j][3] * rstd * gv[3])}; }
}

__device__ __forceinline__ void s5_table_item(int g, int q, const float* a_re, const float* a_im, const float* b_re, const float* b_im, const float* c_re, const float* c_im, const float* dd, const float* log_step,
                                              bf16_t* TB, bf16_t* GT, float* LAMT, float* BBT, LAS float* L, int tid) {
    LAS float* LAMR = L; LAS float* LAMI = L + 2112; LAS float* BBR = L + 4224; LAS float* BBI = L + 5248; LAS float* CR = L + 6272; LAS float* CI = L + 7296; LAS float* KQ = L + 8320;
    const float dt = __expf(log_step[g]);
    for (int idx = tid; idx < 2112; idx += 512) { const int j = idx >> 6, p = idx & 63; const float are = a_re[g * 64 + p], aim = a_im[g * 64 + p];
        const float mag = __expf((float)j * are * dt); const float rev = (float)j * (aim * dt) * 0.15915494309189535f; const float fr = rev - rintf(rev);
        LAMR[idx] = mag * cosf(fr * 6.283185307179586f); LAMI[idx] = mag * sinf(fr * 6.283185307179586f); }
    for (int idx = tid; idx < 1024; idx += 512) { const int p = idx >> 4; const float are = a_re[g * 64 + p], aim = a_im[g * 64 + p];
        const float mag = __expf(are * dt); const float rev = (aim * dt) * 0.15915494309189535f; const float fr = rev - rintf(rev);
        const float lr = mag * cosf(fr * 6.283185307179586f), li = mag * sinf(fr * 6.283185307179586f);
        const float den = are * are + aim * aim, nr = lr - 1.f, ni = li, rr = (nr * are + ni * aim) / den, ri = (ni * are - nr * aim) / den;
        const float br = b_re[g * 1024 + idx], bi = b_im[g * 1024 + idx]; BBR[idx] = rr * br - ri * bi; BBI[idx] = rr * bi + ri * br;
        CR[idx] = c_re[g * 1024 + idx]; CI[idx] = c_im[g * 1024 + idx]; }
    __syncthreads();
    {
        const int cc = tid & 255, jh = tid >> 8, c = cc >> 4, c1 = cc & 15; float a4[4] = {0.f, 0.f, 0.f, 0.f};
        for (int p = 0; p < 64; ++p) { const float cr = CR[c * 64 + p], ci = CI[c * 64 + p], br = BBR[p * 16 + c1], bi = BBI[p * 16 + c1]; const float cbr = cr * br - ci * bi, cbi = cr * bi + ci * br;
#pragma unroll
            for (int e = 0; e < 4; ++e) { const int j = 8 * q + 4 * jh + e; a4[e] += LAMR[j * 64 + p] * cbr - LAMI[j * 64 + p] * cbi; } }
#pragma unroll
        for (int e = 0; e < 4; ++e) { const int j = 8 * q + 4 * jh + e; KQ[(4 * jh + e) * 256 + cc] = a4[e] + ((j == 0 && c == c1) ? dd[g * 16 + c] : 0.f); }
    }
    __syncthreads();
    bf16_t* TBg = TB + (size_t)g * 512 * 640;
    for (int idx = tid; idx < 4096; idx += 512) {
        const int jl = idx >> 9, t = (idx >> 4) & 31, c = idx & 15, j = 8 * q + jl;
        if (t >= j) { const LAS float* k = KQ + jl * 256 + c * 16; u32x4 w0, w1;
            w0.x = cvt_pk_bf16(k[0], k[1]); w0.y = cvt_pk_bf16(k[2], k[3]); w0.z = cvt_pk_bf16(k[4], k[5]); w0.w = cvt_pk_bf16(k[6], k[7]);
            w1.x = cvt_pk_bf16(k[8], k[9]); w1.y = cvt_pk_bf16(k[10], k[11]); w1.z = cvt_pk_bf16(k[12], k[13]); w1.w = cvt_pk_bf16(k[14], k[15]);
            u32x4* d = (u32x4*)(TBg + (size_t)(t * 16 + c) * 640 + (t - j) * 16); d[0] = w0; d[1] = w1; } }
    for (int idx = tid; idx < 4096; idx += 512) {
        const int tl = idx >> 9, c = (idx >> 5) & 15, s = idx & 31, t = 8 * q + tl;
        if (s > t) { u32x4* d = (u32x4*)(TBg + (size_t)(t * 16 + c) * 640 + s * 16); d[0] = (u32x4){0u, 0u, 0u, 0u}; d[1] = (u32x4){0u, 0u, 0u, 0u}; } }
    for (int idx = tid; idx < 16384; idx += 512) {
        const int p = idx & 63, ri = (idx >> 6) & 1, c = (idx >> 7) & 15, tl = idx >> 11, t = 8 * q + tl;
        const float lr = LAMR[(t + 1) * 64 + p], li = LAMI[(t + 1) * 64 + p], cr = CR[c * 64 + p], ci = CI[c * 64 + p];
        const float val = ri == 0 ? (cr * lr - ci * li) : -(cr * li + ci * lr);
        TBg[(size_t)(t * 16 + c) * 640 + 512 + ri * 64 + p] = f2bf(val); }
    bf16_t* GTg = GT + (size_t)g * 256 * 512;
    for (int idx = tid; idx < 16384; idx += 512) {
        const int sc = idx & 511, s = sc >> 4, c1 = sc & 15, r = 32 * q + (idx >> 9), ri = r >> 6, p = r & 63;
        const float lr = LAMR[(31 - s) * 64 + p], li = LAMI[(31 - s) * 64 + p], br = BBR[p * 16 + c1], bi = BBI[p * 16 + c1];
        GTg[(size_t)r * 512 + sc] = f2bf(ri == 0 ? (lr * br - li * bi) : (lr * bi + li * br)); }
    for (int idx = tid; idx < 2048; idx += 512) {
        ((u32x4*)(GTg + (size_t)(128 + 32 * q) * 512))[idx] = (u32x4){0u, 0u, 0u, 0u}; }
    if (q == 0) {
        if (tid < 64) { f32x4 v; v[0] = LAMR[64 + tid]; v[1] = LAMI[64 + tid]; v[2] = LAMR[32 * 64 + tid]; v[3] = LAMI[32 * 64 + tid]; *(f32x4*)(LAMT + (size_t)(g * 64 + tid) * 4) = v; }
        for (int idx = tid; idx < 1024; idx += 512) { *(f32x2*)(BBT + ((size_t)g * 1024 + idx) * 2) = (f32x2){BBR[idx], BBI[idx]}; }
    }
    __syncthreads();
}

__device__ __forceinline__ void hgrn_pre_item(int item, const float* LF, const bf16_t* QB, const bf16_t* VB, bf16_t* PRE, float* DL, LAS float* tot, int tid) {
    const int bh = item >> 5, c = item & 31, b = bh >> 3, h = bh & 7, seg = tid >> 7, k = tid & 127;
    const size_t base = (size_t)(b * 2048 + c * 64 + seg * 16) * WA + h * 128 + k;
    float lf[16], qv[16]; bf16_t vv[16];
#pragma unroll
    for (int i = 0; i < 16; ++i) { lf[i] = LF[base + (size_t)i * WA]; qv[i] = bf2f(QB[base + (size_t)i * WA]); vv[i] = VB[base + (size_t)i * WA]; }
    float pl[16]; float run = 0.f;
#pragma unroll
    for (int i = 0; i < 16; ++i) { run += lf[i]; pl[i] = run; }
    tot[seg * 128 + k] = run;
    __syncthreads();
    float off = 0.f, bl = 0.f;
#pragma unroll
    for (int s = 0; s < 4; ++s) { const float t = tot[s * 128 + k]; if (s < seg) off += t; bl += t; }
    __syncthreads();
    bf16_t* P = PRE + (size_t)item * 32768;
    float kh[16];
#pragma unroll
    for (int i = 0; i < 16; ++i) { const float bc = pl[i] + off, kk = 1.f - __expf(lf[i]);
        P[(seg * 16 + i) * 128 + k] = f2bf(qv[i] * __expf(bc)); P[8192 + (seg * 16 + i) * 128 + k] = f2bf(kk * __expf(-bc)); kh[i] = kk * __expf(bl - bc); }
    u32x4 w0, w1;
    w0.x = cvt_pk_bf16(kh[0], kh[1]); w0.y = cvt_pk_bf16(kh[2], kh[3]); w0.z = cvt_pk_bf16(kh[4], kh[5]); w0.w = cvt_pk_bf16(kh[6], kh[7]);
    w1.x = cvt_pk_bf16(kh[8], kh[9]); w1.y = cvt_pk_bf16(kh[10], kh[11]); w1.z = cvt_pk_bf16(kh[12], kh[13]); w1.w = cvt_pk_bf16(kh[14], kh[15]);
    { u32x4* d = (u32x4*)(P + 16384 + k * 64 + seg * 16); d[0] = w0; d[1] = w1; }
    w0.x = (unsigned)vv[0] | ((unsigned)vv[1] << 16); w0.y = (unsigned)vv[2] | ((unsigned)vv[3] << 16); w0.z = (unsigned)vv[4] | ((unsigned)vv[5] << 16); w0.w = (unsigned)vv[6] | ((unsigned)vv[7] << 16);
    w1.x = (unsigned)vv[8] | ((unsigned)vv[9] << 16); w1.y = (unsigned)vv[10] | ((unsigned)vv[11] << 16); w1.z = (unsigned)vv[12] | ((unsigned)vv[13] << 16); w1.w = (unsigned)vv[14] | ((unsigned)vv[15] << 16);
    { u32x4* d = (u32x4*)(P + 24576 + k * 64 + seg * 16); d[0] = w0; d[1] = w1; }
    if (seg == 0) DL[(size_t)item * 128 + k] = __expf(bl);
}

constexpr int CH_QT = 0, CH_KT = 17408, CH_KH = 34816, CH_VT = 53248, CH_P = 71680, CH_ST = 80896, CH_DL = 115712;
__device__ __forceinline__ bf16x8 ldfrag(const LAS unsigned char* base, int row, int stride, int kb) { return *(const LAS bf16x8*)(base + row * stride + kb); }
__device__ __forceinline__ void hgrn_chain(int b, int h, const bf16_t* PRE, const float* DL, float* ORAW, float* out_state, LAS unsigned char* lds, int tid) {
    const int lane = tid & 63, w = __builtin_amdgcn_readfirstlane(tid >> 6), l15 = lane & 15, lq = lane >> 4;
    f32x4 sacc[8];
#pragma unroll
    for (int i = 0; i < 8; ++i) sacc[i] = (f32x4){0.f, 0.f, 0.f, 0.f};
    for (int i = tid; i < 34816 / 16; i += 512) ((LAS u32x4*)(lds + CH_ST))[i] = (u32x4){0u, 0u, 0u, 0u};
    const int item0 = (b * 8 + h) * 32;
    u32x4 pf[8]; float dlv = 0.f;
    {   const u32x4* src = (const u32x4*)(PRE + (size_t)item0 * 32768);
#pragma unroll
        for (int j = 0; j < 8; ++j) pf[j] = src[tid + 512 * j];
        if (tid < 128) dlv = DL[(size_t)item0 * 128 + tid]; }
    for (int c = 0; c < 32; ++c) {
#pragma unroll
        for (int j = 0; j < 8; ++j) { const int pi = (tid + 512 * j) & 1023; int off;
            if (j < 2) off = CH_QT + (pi >> 4) * 272 + (pi & 15) * 16; else if (j < 4) off = CH_KT + (pi >> 4) * 272 + (pi & 15) * 16;
            else if (j < 6) off = CH_KH + (pi >> 3) * 144 + (pi & 7) * 16; else off = CH_VT + (pi >> 3) * 144 + (pi & 7) * 16;
            *(LAS u32x4*)(lds + off) = pf[j]; }
        if (tid < 128) ((LAS float*)(lds + CH_DL))[tid] = dlv;
        __syncthreads();
        if (c + 1 < 32) { const u32x4* src = (const u32x4*)(PRE + (size_t)(item0 + c + 1) * 32768);
#pragma unroll
            for (int j = 0; j < 8; ++j) pf[j] = src[tid + 512 * j];
            if (tid < 128) dlv = DL[(size_t)(item0 + c + 1) * 128 + tid]; }
        { const int tt = w >> 1;
#pragma unroll
          for (int e = 0; e < 2; ++e) { const int st = (w & 1) * 2 + e; f32x4 a = (f32x4){0.f, 0.f, 0.f, 0.f};
#pragma unroll
            for (int ks = 0; ks < 4; ++ks) a = __builtin_amdgcn_mfma_f32_16x16x32_bf16(ldfrag(lds + CH_KT, 16 * st + l15, 272, (ks * 32 + 8 * lq) * 2), ldfrag(lds + CH_QT, 16 * tt + l15, 272, (ks * 32 + 8 * lq) * 2), a, 0, 0, 0);
            const int t = 16 * tt + l15, s0 = 16 * st + 4 * lq;
#pragma unroll
            for (int j = 0; j < 4; ++j) a[j] = (s0 + j <= t) ? a[j] : 0.f;
            *(LAS u32x2*)(lds + CH_P + t * 144 + s0 * 2) = (u32x2){cvt_pk_bf16(a[0], a[1]), cvt_pk_bf16(a[2], a[3])}; } }
        __syncthreads();
        bf16x8 aV[2], aS[4];
#pragma unroll
        for (int ss = 0; ss < 2; ++ss) aV[ss] = ldfrag(lds + CH_VT, 16 * w + l15, 144, (ss * 32 + 8 * lq) * 2);
#pragma unroll
        for (int ks = 0; ks < 4; ++ks) aS[ks] = ldfrag(lds + CH_ST, 16 * w + l15, 272, (ks * 32 + 8 * lq) * 2);
        const int tok0 = b * 2048 + c * 64;
#pragma unroll
        for (int tt = 0; tt < 4; ++tt) { f32x4 a = (f32x4){0.f, 0.f, 0.f, 0.f};
#pragma unroll
            for (int ss = 0; ss < 2; ++ss) a = __builtin_amdgcn_mfma_f32_16x16x32_bf16(aV[ss], ldfrag(lds + CH_P, 16 * tt + l15, 144, (ss * 32 + 8 * lq) * 2), a, 0, 0, 0);
#pragma unroll
            for (int ks = 0; ks < 4; ++ks) a = __builtin_amdgcn_mfma_f32_16x16x32_bf16(aS[ks], ldfrag(lds + CH_QT, 16 * tt + l15, 272, (ks * 32 + 8 * lq) * 2), a, 0, 0, 0);
            *(f32x4*)(ORAW + (size_t)(tok0 + 16 * tt + l15) * WA + h * 128 + 16 * w + 4 * lq) = a; }
#pragma unroll
        for (int kt = 0; kt < 8; ++kt) { const f32x4 d4 = *(const LAS f32x4*)(lds + CH_DL + (16 * kt + 4 * lq) * 4); sacc[kt] = sacc[kt] * d4;
#pragma unroll
            for (int ss = 0; ss < 2; ++ss) sacc[kt] = __builtin_amdgcn_mfma_f32_16x16x32_bf16(ldfrag(lds + CH_KH, 16 * kt + l15, 144, (ss * 32 + 8 * lq) * 2), aV[ss], sacc[kt], 0, 0, 0); }
        __syncthreads();
#pragma unroll
        for (int kt = 0; kt < 8; ++kt) *(LAS u32x2*)(lds + CH_ST + (16 * w + l15) * 272 + (16 * kt + 4 * lq) * 2) = (u32x2){cvt_pk_bf16(sacc[kt][0], sacc[kt][1]), cvt_pk_bf16(sacc[kt][2], sacc[kt][3])};
    }
    if (out_state) {
#pragma unroll
    for (int kt = 0; kt < 8; ++kt)
#pragma unroll
        for (int j = 0; j < 4; ++j) out_state[((size_t)(b * 8 + h) * 128 + 16 * kt + 4 * lq + j) * 128 + 16 * w + l15] = sacc[kt][j]; }
    __syncthreads();
}

__device__ __forceinline__ void hgrn_sample_item(int bh, const float* LF, const bf16_t* QB, const bf16_t* VB, const float* s0, float* ORAWS, float* out_state, LAS float* red, int tid) {
    const int b = bh >> 3, h = bh & 7, v4 = tid & 31, kr = tid >> 5;
    f32x4 S[8];
#pragma unroll
    for (int i = 0; i < 8; ++i) S[i] = *(const f32x4*)(s0 + ((size_t)bh * 128 + kr + 16 * i) * 128 + 4 * v4);
#pragma unroll
    for (int t = 0; t < 4; ++t) {
        const size_t rb = (size_t)(NPROMPT + b * 4 + t) * WA + h * 128;
        const u32x2 vw = *(const u32x2*)(VB + rb + 4 * v4); const f32x4 vv = (f32x4){bf_lo(vw.x), bf_hi(vw.x), bf_lo(vw.y), bf_hi(vw.y)};
        f32x4 po = (f32x4){0.f, 0.f, 0.f, 0.f};
#pragma unroll
        for (int i = 0; i < 8; ++i) { const int k = kr + 16 * i; const float f = __expf(LF[rb + k]), kk = 1.f - f, q = bf2f(QB[rb + k]);
            S[i] = S[i] * f + vv * kk; po += S[i] * q; }
        *(LAS f32x4*)(red + kr * 128 + 4 * v4) = po;
        __syncthreads();
        if (tid < 128) { float s = 0.f;
#pragma unroll
            for (int j = 0; j < 16; ++j) s += red[j * 128 + tid];
            ORAWS[(size_t)(b * 4 + t) * WA + h * 128 + tid] = s; }
        __syncthreads();
    }
    if (out_state) {
#pragma unroll
    for (int i = 0; i < 8; ++i) *(f32x4*)(out_state + ((size_t)bh * 128 + kr + 16 * i) * 128 + 4 * v4) = S[i]; }
}

__device__ __forceinline__ void s5_scan(int g, const float* XLOC, const float* LAMT, bf16_t* UG, float* o_rp, float* o_ip, int tid) {
    if (tid < 256) { const int b = tid >> 6, p = tid & 63; const f32x4 lm = *(const f32x4*)(LAMT + (size_t)(g * 64 + p) * 4); const float l32r = lm[2], l32i = lm[3];
        float cr = 0.f, ci = 0.f;
        for (int cb = 0; cb < 4; ++cb) { float xr[16], xi[16];
#pragma unroll
            for (int i = 0; i < 16; ++i) { const size_t row = (size_t)g * 256 + b * 64 + cb * 16 + i; xr[i] = XLOC[row * 128 + p]; xi[i] = XLOC[row * 128 + 64 + p]; }
#pragma unroll
            for (int i = 0; i < 16; ++i) { const size_t row = (size_t)g * 256 + b * 64 + cb * 16 + i;
                UG[row * 640 + 512 + p] = f2bf(cr); UG[row * 640 + 576 + p] = f2bf(ci);
                const float nr = l32r * cr - l32i * ci + xr[i], ni = l32r * ci + l32i * cr + xi[i]; cr = nr; ci = ni; } }
        if (o_rp) o_rp[(size_t)(b * 64 + g) * 64 + p] = cr; if (o_ip) o_ip[(size_t)(b * 64 + g) * 64 + p] = ci; }
    __threadfence();
    __syncthreads();
}

__device__ __forceinline__ void s5_sample_item(int item, const bf16_t* US, const float* LAMT, const float* BBT, const float* c_re, const float* c_im, const float* dd, const float* x0r, const float* x0i,
                                               bf16_t* YBUF, float* o_rs, float* o_is, LAS float* L, int tid) {
    const int g = item >> 4, b = (item & 15) * 8 + (tid >> 6), lane = tid & 63, wv = tid >> 6;
    LAS float* CRs = L; LAS float* CIs = L + 16 * 65; LAS float* XS = L + 2 * 16 * 65 + wv * 512;
    for (int idx = tid; idx < 1024; idx += 512) { const int c = idx >> 6, p = idx & 63; CRs[c * 65 + p] = c_re[g * 1024 + idx]; CIs[c * 65 + p] = c_im[g * 1024 + idx]; }
    const f32x4 lm = *(const f32x4*)(LAMT + (size_t)(g * 64 + lane) * 4);
    float xr = x0r[(size_t)(b * 64 + g) * 64 + lane], xi = x0i[(size_t)(b * 64 + g) * 64 + lane];
    float bbr[16], bbi[16];
#pragma unroll
    for (int c = 0; c < 16; c += 2) { const f32x4 v = *(const f32x4*)(BBT + ((size_t)(g * 64 + lane) * 16 + c) * 2); bbr[c] = v[0]; bbi[c] = v[1]; bbr[c + 1] = v[2]; bbi[c + 1] = v[3]; }
    float myu = 0.f;
#pragma unroll
    for (int t = 0; t < 4; ++t) {
        const u32x4* up = (const u32x4*)(US + (size_t)(b * 4 + t) * WA + g * 16); const u32x4 u0 = up[0], u1 = up[1];
        const float u[16] = {bf_lo(u0.x), bf_hi(u0.x), bf_lo(u0.y), bf_hi(u0.y), bf_lo(u0.z), bf_hi(u0.z), bf_lo(u0.w), bf_hi(u0.w), bf_lo(u1.x), bf_hi(u1.x), bf_lo(u1.y), bf_hi(u1.y), bf_lo(u1.z), bf_hi(u1.z), bf_lo(u1.w), bf_hi(u1.w)};
        float br = 0.f, bi = 0.f;
#pragma unroll
        for (int c = 0; c < 16; ++c) { br += bbr[c] * u[c]; bi += bbi[c] * u[c]; if ((lane >> 4) == t && (lane & 15) == c) myu = u[c]; }
        const float nr = lm[0] * xr - lm[1] * xi + br, ni = lm[0] * xi + lm[1] * xr + bi; xr = nr; xi = ni;
        XS[(t * 2 + 0) * 64 + lane] = xr; XS[(t * 2 + 1) * 64 + lane] = xi;
    }
    if (o_rs) o_rs[(size_t)(b * 64 + g) * 64 + lane] = xr; if (o_is) o_is[(size_t)(b * 64 + g) * 64 + lane] = xi;
    __syncthreads();
    { const int t = lane >> 4, c = lane & 15; float y = 0.f;
      for (int p = 0; p < 64; ++p) y += CRs[c * 65 + p] * XS[(t * 2) * 64 + p] - CIs[c * 65 + p] * XS[(t * 2 + 1) * 64 + p];
      y += dd[g * 16 + c] * myu;
      YBUF[(size_t)(NPROMPT + b * 4 + t) * WA + g * 16 + c] = f2bf(gelu_tanh_f(y)); }
    __syncthreads();
}

__device__ __forceinline__ void gate_row(int tok, const float* ORAW, const float* ORAWS, const bf16_t* GB, const float* ng, bf16_t* MIX, int lane) {
    const float* orow = tok < NPROMPT ? ORAW + (size_t)tok * WA : ORAWS + (size_t)(tok - NPROMPT) * WA;
    f32x4 v[4]; float s = 0.f;
#pragma unroll
    for (int j = 0; j < 4; ++j) { v[j] = ((const f32x4*)orow)[lane + 64 * j]; s += (v[j][0] * v[j][0] + v[j][1] * v[j][1]) + (v[j][2] * v[j][2] + v[j][3] * v[j][3]); }
    const float rstd = rsqrtf(wave_sum(s) * (1.f / WA) + 1e-6f);
#pragma unroll
    for (int j = 0; j < 4; ++j) { const f32x4 gv = ((const f32x4*)ng)[lane + 64 * j]; const u32x2 gw = ((const u32x2*)(GB + (size_t)tok * WA))[lane + 64 * j];
        ((u32x2*)(MIX + (size_t)tok * DM))[lane + 64 * j] = (u32x2){cvt_pk_bf16(v[j][0] * rstd * gv[0] * bf_lo(gw.x), v[j][1] * rstd * gv[1] * bf_hi(gw.x)), cvt_pk_bf16(v[j][2] * rstd * gv[2] * bf_lo(gw.y), v[j][3] * rstd * gv[3] * bf_hi(gw.y))}; }
}

__device__ __forceinline__ void final_row(int tok, float* X1, const bf16_t* PART, const float* gf, int lane) {
    f32x4* xr = (f32x4*)(X1 + (size_t)tok * DM); f32x4 v[8]; float s = 0.f;
#pragma unroll
    for (int j = 0; j < 8; ++j) { v[j] = xr[lane + 64 * j];
#pragma unroll
        for (int z = 0; z < 4; ++z) { const u32x2 pw = ((const u32x2*)(PART + ((size_t)z * NTOK + tok) * DM))[lane + 64 * j]; v[j][0] += bf_lo(pw.x); v[j][1] += bf_hi(pw.x); v[j][2] += bf_lo(pw.y); v[j][3] += bf_hi(pw.y); }
        s += (v[j][0] * v[j][0] + v[j][1] * v[j][1]) + (v[j][2] * v[j][2] + v[j][3] * v[j][3]); }
    const float rstd = rsqrtf(wave_sum(s) * (1.f / DM) + 1e-6f);
#pragma unroll
    for (int j = 0; j < 8; ++j) { const f32x4 gv = ((const f32x4*)gf)[lane + 64 * j]; xr[lane + 64 * j] = (f32x4){v[j][0] * rstd * gv[0], v[j][1] * rstd * gv[1], v[j][2] * rstd * gv[2], v[j][3] * rstd * gv[3]}; }
}
constexpr int LDS_BYTES = 147456, NPH = 9;
struct Args { const float* in[24]; float* out; unsigned char* ws; int ph_lo, ph_hi, coop, omask; };

__global__ void __launch_bounds__(512, 2) mk(Args a) {
    extern __shared__ __attribute__((aligned(16))) unsigned char lds_raw[];
    LAS unsigned char* lds = (LAS unsigned char*)lds_raw;
    cg::grid_group grid = cg::this_grid();
    const int tid = threadIdx.x, lane = tid & 63, wave = __builtin_amdgcn_readfirstlane(tid >> 6), G = gridDim.x, blk = blockIdx.x;
    const int gw = blk * 8 + wave, NGW = G * 8;
    unsigned char* ws = a.ws; float* out = a.out;
    const float *x_p = a.in[0], *x_s = a.in[1];
    bf16_t* UG = (bf16_t*)(ws + WS_UG); float* XLOC = (float*)(ws + WS_XLOC); bf16_t* US = (bf16_t*)(ws + WS_US); bf16_t* WTDOWN = (bf16_t*)(ws + WS_WTDOWN);
    bf16_t* HB = (bf16_t*)(ws + WS_HB); bf16_t* YBUF = (bf16_t*)(ws + WS_YBUF); bf16_t* QB = (bf16_t*)(ws + WS_QB); bf16_t* VB = (bf16_t*)(ws + WS_VB); bf16_t* GB = (bf16_t*)(ws + WS_GB);
    float* LF = (float*)(ws + WS_LF); float* ORAW = LF; bf16_t* WTGLU = (bf16_t*)(ws + WS_WTGLU); bf16_t* WTOUT = (bf16_t*)(ws + WS_WTOUT); bf16_t* HH = (bf16_t*)(ws + WS_H);
    bf16_t* WTIN = (bf16_t*)(ws + WS_WTIN); bf16_t* PRE = (bf16_t*)(ws + WS_PRE); bf16_t* WTUP = (bf16_t*)(ws + WS_WTUP); bf16_t* A2 = (bf16_t*)(ws + WS_A2); bf16_t* TB = (bf16_t*)(ws + WS_TB);
    bf16_t* MIX = (bf16_t*)(ws + WS_MIX); bf16_t* GT = (bf16_t*)(ws + WS_GT); bf16_t* PART = (bf16_t*)(ws + WS_PART);
    float* SS2 = (float*)(ws + WS_SS2); float* LB = (float*)(ws + WS_LB); float* LAMT = (float*)(ws + WS_LAMT); float* BBT = (float*)(ws + WS_BBT); float* DL = (float*)(ws + WS_DL); float* ORAWS = (float*)(ws + WS_ORAWS);
    float* X1 = out + O_YP;
    float* o_hp = (a.omask & 4) ? out + O_HP : nullptr; float* o_rp = (a.omask & 8) ? out + O_RP : nullptr; float* o_ip = (a.omask & 16) ? out + O_IP : nullptr;
    float* o_hs = (a.omask & 32) ? out + O_HS : nullptr; float* o_rs = (a.omask & 64) ? out + O_RS : nullptr; float* o_is = (a.omask & 128) ? out + O_IS : nullptr;
    const int lo = a.ph_lo, hi = a.ph_hi;
#define IN(k) (lo <= (k) && (k) < hi)
#define SEAM(k) do { if (IN(k) && IN((k) + 1) && a.coop) grid.sync(); } while (0)

    if (IN(0)) {
        for (int it = blk; it < 256; it += G) s5_table_item(it >> 2, it & 3, a.in[11], a.in[12], a.in[13], a.in[14], a.in[15], a.in[16], a.in[17], a.in[18], TB, GT, LAMT, BBT, (LAS float*)lds, tid);
        for (int i = blk * 512 + tid; i < NTOK; i += G * 512) SS2[i] = 0.f;
        for (int i = blk * 512 + tid; i < WA; i += G * 512) { const float e0 = __expf(a.in[9][i]), e1 = __expf(a.in[9][WA + i]); LB[i] = e0 / (e0 + e1); }
        LAS float* scr = (LAS float*)(lds + wave * 16384);
        constexpr int I_IN = (DM / 64) * (INC / 32), I_GLU = (WA / 64) * (WA / 32), I_OUT = (DM / 64) * (DM / 32);
        for (int it = gw; it < I_IN + I_GLU + I_OUT; it += NGW) {
            if (it < I_IN) transpose_item(a.in[5], DM, INC, WTIN, scr, it, lane, nullptr);
            else if (it < I_IN + I_GLU) transpose_item(a.in[19], WA, WA, WTGLU, scr, it - I_IN, lane, nullptr);
            else transpose_item(a.in[6], DM, DM, WTOUT, scr, it - I_IN - I_GLU, lane, nullptr);
        }
        for (int r = gw; r < NTOK; r += NGW) rms_row_bf16(r < NPROMPT ? x_p + (size_t)r * DM : x_s + (size_t)(r - NPROMPT) * DM, a.in[7], HB + (size_t)r * DM, lane);
        __syncthreads();
    }
    SEAM(0);
    if (IN(1)) {
        pg8::Gemm g{HB, WTIN, DM, DM, DM}; pg8::TileOrder S; S.init(NTOK, INC, 1, G, blk);
        pg8::Epi1 E{ws, LB};
        pg8::gemm_phase<pg8::Epi1, pg8::TileOrder, true, true>(lds, g, S, E);
    }
    SEAM(1);
    if (IN(2)) {
        { pg8::Gemm g{UG, GT, 512, 640, 512}; pg8::GroupOrder S{0, 64, 1, G, blk, (size_t)256 * 640, (size_t)256 * 512}; pg8::EpiS1 E{XLOC};
          pg8::gemm_phase<pg8::EpiS1, pg8::GroupOrder, true, true>(lds, g, S, E); }
        __syncthreads();
        const int nfree = G > 64 ? G - 64 : G, fb = G > 64 ? blk - 64 : blk;
        if (fb >= 0) for (int it = fb; it < 1024; it += nfree) hgrn_pre_item(it, LF, QB, VB, PRE, DL, (LAS float*)lds, tid);
        __syncthreads();
    }
    SEAM(2);
    if (IN(3)) {
        if (blk < 32) { hgrn_chain(blk >> 3, blk & 7, PRE, DL, ORAW, o_hp, lds, tid); }
        else if (blk < 96) { const int g = blk - 32; s5_scan(g, XLOC, LAMT, UG, o_rp, o_ip, tid);
            pg8::Gemm gm{UG, TB, 640, 640, 640}; pg8::GroupOrder S{g, 1, 2, 1, 0, (size_t)256 * 640, (size_t)512 * 640}; pg8::EpiS2 E{YBUF};
            pg8::gemm_phase<pg8::EpiS2, pg8::GroupOrder, true, true>(lds, gm, S, E); }
        else { const int r = blk - 96, nr = G - 96;
            for (int it = r; it < 1024; it += nr) hgrn_sample_item(it, LF, QB, VB, a.in[2], ORAWS, o_hs, (LAS float*)lds, tid);
            __syncthreads();
            for (int it = r; it < 1024; it += nr) s5_sample_item(it, US, LAMT, BBT, a.in[15], a.in[16], a.in[17], a.in[3], a.in[4], YBUF, o_rs, o_is, (LAS float*)lds, tid); }
        __syncthreads();
    }
    SEAM(3);
    if (IN(4)) {
        { pg8::Gemm g{YBUF, WTGLU, WA, WA, WA}; pg8::TileOrder S; S.init(NTOK, WA, 1, G, blk); pg8::EpiGlu E{YBUF, a.in[20], MIX};
          pg8::gemm_phase<pg8::EpiGlu, pg8::TileOrder, true, true>(lds, g, S, E); }
        __syncthreads();
        const int ngemm = G >= 136 ? 136 : G, nfreew = (G - ngemm) * 8, nslot = nfreew * 2 + ngemm * 8;
        constexpr int I_UP = (DM / 64) * (DFF / 32), I_DN = (DFF / 64) * (DM / 32), I_ALL = I_UP + I_DN + NTOK;
        LAS float* scr = (LAS float*)(lds + wave * 16384);
        const int nmine = blk >= ngemm ? 2 : 1;
        for (int sl = 0; sl < nmine; ++sl) { const int slot = blk >= ngemm ? ((blk - ngemm) * 8 + wave) * 2 + sl : nfreew * 2 + blk * 8 + wave;
            for (int it = slot; it < I_ALL; it += nslot) {
                if (it < I_UP) transpose_item(a.in[21], DM, DFF, WTUP, scr, it, lane, a.in[8]);
                else if (it < I_UP + I_DN) transpose_item(a.in[22], DFF, DM, WTDOWN, scr, it - I_UP, lane, nullptr);
                else gate_row(it - I_UP - I_DN, ORAW, ORAWS, GB, a.in[10], MIX, lane);
            } }
        __syncthreads();
    }
    SEAM(4);
    if (IN(5)) {
        pg8::Gemm g{MIX, WTOUT, DM, DM, DM}; pg8::TileOrder S; S.init(NTOK, DM, 1, G, blk); pg8::EpiOut E{x_p, x_s, X1, A2, SS2};
        pg8::gemm_phase<pg8::EpiOut, pg8::TileOrder, true, true>(lds, g, S, E);
    }
    SEAM(5);
    if (IN(6)) {
        pg8::Gemm g{A2, WTUP, DM, DM, DM}; pg8::TileOrder S; S.init(NTOK, DFF, 1, G, blk); pg8::EpiUp E{SS2, HH};
        pg8::gemm_phase<pg8::EpiUp, pg8::TileOrder, true, true>(lds, g, S, E);
    }
    SEAM(6);
    if (IN(7)) {
        pg8::Gemm g{HH, WTDOWN, DM, DFF, DFF}; pg8::TileOrder S; S.init(NTOK, DM, 4, G, blk); pg8::EpiDown E{PART};
        pg8::gemm_phase<pg8::EpiDown, pg8::TileOrder, true, true>(lds, g, S, E);
    }
    SEAM(7);
    if (IN(8)) { for (int r = gw; r < NTOK; r += NGW) final_row(r, X1, PART, a.in[23], lane); }
#undef IN
#undef SEAM
}

static int mk_grid = 0;
static void mk_setup() {
    if (mk_grid) return;
    int dev = 0, cus = 0, per_cu = 0;
    (void)hipGetDevice(&dev); (void)hipDeviceGetAttribute(&cus, hipDeviceAttributeMultiprocessorCount, dev);
    (void)hipFuncSetAttribute((const void*)mk, hipFuncAttributeMaxDynamicSharedMemorySize, LDS_BYTES);
    (void)hipOccupancyMaxActiveBlocksPerMultiprocessor(&per_cu, (const void*)mk, 512, LDS_BYTES);
    (void)hipGetLastError();
    mk_grid = cus > 0 ? cus : 256;
    fprintf(stderr, "mk_setup: cus %d per_cu %d grid %d\n", cus, per_cu, mk_grid);
}
static void mk_launch(void* const* d_in, void* d_out, void* d_ws, hipStream_t stream, int lo, int hi, int coop, int omask) {
    mk_setup();
    Args a{};
    for (int i = 0; i < 24; ++i) a.in[i] = (const float*)d_in[i];
    a.out = (float*)d_out; a.ws = (unsigned char*)d_ws; a.ph_lo = lo; a.ph_hi = hi; a.coop = coop; a.omask = omask;
    void* args[] = {&a};
    hipError_t e;
    if (coop) e = hipLaunchCooperativeKernel((const void*)mk, dim3(mk_grid), dim3(512), args, LDS_BYTES, stream);
    else { hipLaunchKernelGGL(mk, dim3(mk_grid), dim3(512), LDS_BYTES, stream, a); e = hipPeekAtLastError(); }
    if (e != hipSuccess) fprintf(stderr, "mk launch failed: %s (grid %d, phases %d..%d)\n", hipGetErrorString(e), mk_grid, lo, hi);
}
extern "C" void kernel_launch(void* const* d_in, const int* in_sizes, int n_in, void* d_out, int out_size, void* d_ws, size_t ws_size, hipStream_t stream) {
    if (ws_size < WS_END || n_in < 24) { fprintf(stderr, "kernel_launch: ws %zu < %zu or n_in %d < 24; nothing launched\n", ws_size, (size_t)WS_END, n_in); return; }
    mk_launch(d_in, d_out, d_ws, stream, 0, NPH, 1, 0xFF);
}
```

```cpp
#include <hip/hip_runtime.h>
#include <hip/hip_cooperative_groups.h>
#include <cstdio>
#include <cstdint>
namespace cg = cooperative_groups;

#define LAS __attribute__((address_space(3)))
typedef unsigned short bf16_t;
typedef short bf16x8 __attribute__((ext_vector_type(8)));
typedef float f32x4 __attribute__((ext_vector_type(4)));
typedef float f32x2 __attribute__((ext_vector_type(2)));
typedef unsigned u32x4 __attribute__((ext_vector_type(4)));
typedef unsigned u32x2 __attribute__((ext_vector_type(2)));

__device__ __forceinline__ unsigned cvt_pk_bf16(float lo, float hi) { unsigned r; asm volatile("v_cvt_pk_bf16_f32 %0, %1, %2" : "=v"(r) : "v"(lo), "v"(hi)); return r; }
__device__ __forceinline__ float bf_lo(unsigned w) { return __uint_as_float(w << 16); }
__device__ __forceinline__ float bf_hi(unsigned w) { return __uint_as_float(w & 0xffff0000u); }
__device__ __forceinline__ float bf2f(bf16_t v) { return __uint_as_float(((unsigned)v) << 16); }
__device__ __forceinline__ bf16_t f2bf(float f) { return (bf16_t)(cvt_pk_bf16(f, 0.f) & 0xffffu); }
__device__ __forceinline__ float sigm_f(float v) { return __builtin_amdgcn_rcpf(1.f + __expf(-v)); }
__device__ __forceinline__ float silu_f(float v) { return v * __builtin_amdgcn_rcpf(1.f + __expf(-v)); }
__device__ __forceinline__ float gelu_tanh_f(float v) { const float u = 1.5957691216057308f * (v + 0.044715f * v * v * v); return v * __builtin_amdgcn_rcpf(1.f + __expf(-u)); }
__device__ __forceinline__ float wave_sum(float v) {
#pragma unroll
    for (int o = 1; o < 64; o <<= 1) v += __shfl_xor(v, o);
    return v;
}
#define LDS_WAIT() asm volatile("s_waitcnt lgkmcnt(0)" ::: "memory")

constexpr int NTOK = 8704, NPROMPT = 8192, DM = 2048, DFF = 8192, INC = 5120, WA = 1024;
constexpr size_t MiB = 1048576;
constexpr size_t WS_UG = 0, WS_XLOC = 20 * MiB, WS_US = 28 * MiB, WS_WTDOWN = 0;
constexpr size_t WS_HB = 32 * MiB, WS_YBUF = 32 * MiB, WS_QB = 66 * MiB, WS_VB = 83 * MiB, WS_GB = 100 * MiB, WS_LF = 117 * MiB, WS_WTGLU = 151 * MiB, WS_WTOUT = 153 * MiB, WS_H = 32 * MiB;
constexpr size_t WS_WTIN = 168 * MiB, WS_PRE = 168 * MiB, WS_WTUP = 168 * MiB, WS_A2 = 200 * MiB, WS_TB = 234 * MiB, WS_MIX = 234 * MiB, WS_GT = 274 * MiB, WS_PART = 168 * MiB;
constexpr size_t WS_MISC = 304 * MiB, WS_SS2 = WS_MISC, WS_LB = WS_MISC + 65536, WS_LAMT = WS_MISC + 131072, WS_BBT = WS_MISC + 262144, WS_DL = WS_MISC + MiB, WS_ORAWS = WS_MISC + 2 * MiB, WS_END = 308 * MiB;
constexpr size_t O_YP = 0, O_HP = 17825792, O_RP = 18350080, O_IP = 18366464, O_HS = 18382848, O_RS = 35160064, O_IS = 35684352;
namespace pg8 {
#define PG8_LAS __attribute__((address_space(3)))
constexpr int BM = 256, BK = 64, HALF = 128, HTB = HALF * BK * 2  , STAGE_BYTES = 8 * HTB, NXCD = 8, WGM = 8;
__host__ __device__ __forceinline__ int lds_byte(int r, int c) { const int st = (r >> 4) * 2 + (c >> 5), rr = r & 15, cc = c & 31, ob = rr * 64 + cc * 2; return st * 1024 + (ob ^ (((ob >> 9) & 1) << 5)); }
__host__ __device__ __forceinline__ void stage_rc(int b, int& R, int& C) { const int st = b / 1024, sb = b % 1024, swz = sb ^ (((sb >> 9) & 1) << 5); R = (st >> 1) * 16 + swz / 64; C = (st & 1) * 32 + (swz % 64) / 2; }
__host__ __device__ __forceinline__ int perm32(int rho) { const int n = rho >> 4, i = rho & 15; return 8 * (i >> 2) + 4 * n + (i & 3); }
struct Unit { int pm, pn, z; };
struct Gemm { const bf16_t* A; const bf16_t* Bt; int K, lda, ldb; };

struct TileOrder {
    int nM, nN, nwg, nZ, G, c;
    __device__ __forceinline__ void init(int M, int N, int nZ_, int G_, int c_) { nM = M / BM; nN = N / BM; nwg = nM * nN; nZ = nZ_; G = G_; c = c_; }
    __device__ __forceinline__ bool next(int i, Unit& u) const {
        const long L = (long)i * G + c; if (L >= (long)nwg * nZ) return false;
        u.z = (int)(L / nwg); int wgid = (int)(L % nwg); { const int q = nwg / NXCD, r = nwg % NXCD, xcd = wgid % NXCD, off = wgid / NXCD; wgid = (xcd < r ? xcd * (q + 1) : r * (q + 1) + (xcd - r) * q) + off; }
        const int nig = WGM * nN, gid = wgid / nig, fm = gid * WGM, gsz = (nM - fm) < WGM ? (nM - fm) : WGM;
        u.pm = fm + ((wgid % nig) % gsz); u.pn = (wgid % nig) / gsz; return true;
    }
    __device__ __forceinline__ const char* a_base(const Gemm& g, const Unit& u) const { return (const char*)(g.A + (size_t)u.pm * BM * g.lda + (size_t)u.z * g.K); }
    __device__ __forceinline__ const char* b_base(const Gemm& g, const Unit& u) const { return (const char*)(g.Bt + (size_t)u.pn * BM * g.ldb + (size_t)u.z * g.K); }
    __device__ __forceinline__ void a_ready(const Unit&) const {}
    __device__ __forceinline__ void done(const Unit&) const {}
};
struct GroupOrder {
    int g0, ng, npn, G, c; size_t a_gstride, b_gstride;
    __device__ __forceinline__ bool next(int i, Unit& u) const { const int per = i / npn, gi = per * G + c; if (gi >= ng) return false; u.pm = 0; u.pn = i % npn; u.z = g0 + gi; return true; }
    __device__ __forceinline__ const char* a_base(const Gemm& g, const Unit& u) const { return (const char*)(g.A + (size_t)u.z * a_gstride); }
    __device__ __forceinline__ const char* b_base(const Gemm& g, const Unit& u) const { return (const char*)(g.Bt + (size_t)u.z * b_gstride + (size_t)u.pn * BM * g.ldb); }
    __device__ __forceinline__ void a_ready(const Unit&) const {}
    __device__ __forceinline__ void done(const Unit&) const {}
};
template <class Epi, class Sched, bool ALIGN_EPI = false, bool SP2 = false>
__device__ __forceinline__ void gemm_phase(PG8_LAS unsigned char* lds, const Gemm g, const Sched& S, const Epi& E) {
    const int tid = threadIdx.x, wid = __builtin_amdgcn_readfirstlane(tid >> 6), lane = tid & 63, wr = wid >> 2, wc = wid & 3, fr = lane & 15, fq = lane >> 4;
    const int K = g.K, nt = K / BK, lda = g.lda, ldb = g.ldb;
    unsigned voffA[2], voffB[2];
#pragma unroll
    for (int i = 0; i < 2; ++i) { int R, C; stage_rc(tid * 16 + i * 8192, R, C); const int Rb = Epi::PERM ? ((R & ~31) + perm32(R & 31)) : R;
        voffA[i] = (unsigned)(R * lda + C) * 2u; voffB[i] = (unsigned)(Rb * ldb + C) * 2u; }
    const size_t kstep = (size_t)(BK * 2);
    const size_t hstepA = (size_t)HALF * lda * 2, hstepB = (size_t)HALF * ldb * 2;
    const unsigned ldsw = (unsigned)wid * 1024u;
    const int aoff = lds_byte(wr * 64 + fr, fq * 8), boff = lds_byte(wc * 32 + fr, fq * 8);
#define PG8_SA(b, h) (((b) * 2 + (h)) * HTB)
#define PG8_SB(b, h) ((4 + (b) * 2 + (h)) * HTB)
#define PG8_STAGE(bufoff, gbase, voff) do { _Pragma("unroll") for (int _i = 0; _i < 2; ++_i) \
        __builtin_amdgcn_global_load_lds((const unsigned*)((const char*)(gbase) + (voff)[_i]), (PG8_LAS unsigned*)(lds + (bufoff) + ldsw + _i * 8192), 16, 0, 0); } while (0)
#define PG8_LDA(dst, b, h) do { _Pragma("unroll") for (int m = 0; m < 4; ++m) _Pragma("unroll") for (int k = 0; k < 2; ++k) dst[m][k] = *(const PG8_LAS bf16x8*)(lds + PG8_SA(b, h) + aoff + m * 2048 + k * 1024); } while (0)
#define PG8_LDB(dst, b, h) do { _Pragma("unroll") for (int n = 0; n < 2; ++n) _Pragma("unroll") for (int k = 0; k < 2; ++k) dst[n][k] = *(const PG8_LAS bf16x8*)(lds + PG8_SB(b, h) + boff + n * 2048 + k * 1024); } while (0)
#define PG8_MMA(ai, bj, At, Bt) do { __builtin_amdgcn_s_setprio(1); _Pragma("unroll") for (int m = 0; m < 4; ++m) _Pragma("unroll") for (int n = 0; n < 2; ++n) _Pragma("unroll") for (int k = 0; k < 2; ++k) \
        acc[ai][bj][m][n] = __builtin_amdgcn_mfma_f32_16x16x32_bf16(Bt[n][k], At[m][k], acc[ai][bj][m][n], 0, 0, 0); __builtin_amdgcn_s_setprio(0); } while (0)
#define PG8_WAIT_V(n) asm volatile("s_waitcnt vmcnt(" #n ")" ::: "memory")
#define PG8_WAIT_L(n) asm volatile("s_waitcnt lgkmcnt(" #n ")" ::: "memory")
#define PG8_BAR __builtin_amdgcn_s_barrier()
#define PG8_SCHED __builtin_amdgcn_sched_barrier(0)
    Unit cur, nxt; int ui = 0;
    if (!S.next(0, cur)) return;
    f32x4 acc[2][2][4][2];
#pragma unroll
    for (int a = 0; a < 2; ++a)
#pragma unroll
        for (int b = 0; b < 2; ++b)
#pragma unroll
            for (int m = 0; m < 4; ++m)
#pragma unroll
                for (int n = 0; n < 2; ++n) acc[a][b][m][n] = (f32x4){0.f, 0.f, 0.f, 0.f};
    bf16x8 At[4][2], B0[2][2], B1[2][2];
    const char* cA = S.a_base(g, cur); const char* cB = S.b_base(g, cur);
    S.a_ready(cur);
    if constexpr (SP2) {
        PG8_STAGE(PG8_SB(0, 0), cB, voffB); PG8_STAGE(PG8_SB(0, 1), cB + hstepB, voffB); PG8_STAGE(PG8_SA(0, 0), cA, voffA); PG8_STAGE(PG8_SA(0, 1), cA + hstepA, voffA);
        if (wr == 1) PG8_BAR;
        PG8_WAIT_V(2); PG8_BAR;
        PG8_STAGE(PG8_SB(1, 0), cB + kstep, voffB); PG8_STAGE(PG8_SA(1, 0), cA + kstep, voffA); PG8_STAGE(PG8_SB(1, 1), cB + hstepB + kstep, voffB);
        PG8_WAIT_V(6); PG8_BAR;
    } else {
        PG8_STAGE(PG8_SB(0, 0), cB, voffB); PG8_STAGE(PG8_SA(0, 0), cA, voffA); PG8_STAGE(PG8_SB(0, 1), cB + hstepB, voffB); PG8_STAGE(PG8_SA(0, 1), cA + hstepA, voffA);
        if (wr == 1) PG8_BAR;
        PG8_WAIT_V(4); PG8_BAR;
        PG8_STAGE(PG8_SB(1, 0), cB + kstep, voffB); PG8_STAGE(PG8_SA(1, 0), cA + kstep, voffA); PG8_STAGE(PG8_SB(1, 1), cB + hstepB + kstep, voffB);
        PG8_WAIT_V(6); PG8_BAR;
    }
    for (;;) {
        const bool has_next = S.next(ui + 1, nxt);
        const char* nA = has_next ? S.a_base(g, nxt) : cA; const char* nB = has_next ? S.b_base(g, nxt) : cB;
        for (int t = 0; t < nt; t += 2) {
            const bool last = (t == nt - 2);
            const char* a1 = cA + (size_t)(t + 1) * kstep;
            const char* a2 = last ? nA : cA + (size_t)(t + 2) * kstep; const char* b2 = last ? nB : cB + (size_t)(t + 2) * kstep;
            const char* a3 = a2 + kstep; const char* b3 = b2 + kstep;
            if (last && has_next) S.a_ready(nxt);
            if constexpr (SP2) {
            PG8_LDB(B0, 0, 0); PG8_LDB(B1, 0, 1); PG8_SCHED; PG8_LDA(At, 0, 0); PG8_STAGE(PG8_SA(1, 1), a1 + hstepA, voffA);
            PG8_WAIT_V(8); PG8_WAIT_L(0); PG8_BAR; PG8_MMA(0, 0, At, B0); PG8_MMA(0, 1, At, B1); PG8_BAR; PG8_SCHED;
            PG8_LDA(At, 0, 1); PG8_STAGE(PG8_SB(0, 0), b2, voffB); PG8_STAGE(PG8_SB(0, 1), b2 + hstepB, voffB); PG8_STAGE(PG8_SA(0, 0), a2, voffA);
            PG8_WAIT_V(8); PG8_WAIT_L(0); PG8_BAR; PG8_MMA(1, 0, At, B0); PG8_MMA(1, 1, At, B1); PG8_BAR; PG8_SCHED;
            PG8_LDB(B0, 1, 0); PG8_LDB(B1, 1, 1); PG8_SCHED; PG8_LDA(At, 1, 0); PG8_STAGE(PG8_SA(0, 1), a2 + hstepA, voffA);
            PG8_WAIT_V(8); PG8_WAIT_L(0); PG8_BAR; PG8_MMA(0, 0, At, B0); PG8_MMA(0, 1, At, B1); PG8_BAR; PG8_SCHED;
            PG8_LDA(At, 1, 1); PG8_STAGE(PG8_SB(1, 0), b3, voffB); PG8_STAGE(PG8_SB(1, 1), b3 + hstepB, voffB); PG8_STAGE(PG8_SA(1, 0), a3, voffA);
            PG8_WAIT_V(8); PG8_WAIT_L(0); PG8_BAR; PG8_MMA(1, 0, At, B0); PG8_MMA(1, 1, At, B1); PG8_BAR; PG8_SCHED;
            } else {
            PG8_LDB(B0, 0, 0); PG8_SCHED; PG8_LDA(At, 0, 0); PG8_STAGE(PG8_SA(1, 1), a1 + hstepA, voffA);
            PG8_WAIT_L(8); PG8_BAR; PG8_WAIT_L(0); PG8_MMA(0, 0, At, B0); PG8_BAR; PG8_SCHED;
            PG8_LDB(B1, 0, 1); PG8_STAGE(PG8_SB(0, 0), b2, voffB);
            PG8_BAR; PG8_WAIT_L(0); PG8_MMA(0, 1, At, B1); PG8_BAR;
            PG8_LDA(At, 0, 1); PG8_STAGE(PG8_SA(0, 0), a2, voffA);
            PG8_BAR; PG8_WAIT_L(0); PG8_MMA(1, 0, At, B0); PG8_BAR; PG8_SCHED;
            PG8_STAGE(PG8_SB(0, 1), b2 + hstepB, voffB);
            PG8_WAIT_V(6); PG8_BAR; PG8_MMA(1, 1, At, B1); PG8_BAR;
            PG8_LDB(B0, 1, 0); PG8_SCHED; PG8_LDA(At, 1, 0); PG8_STAGE(PG8_SA(0, 1), a2 + hstepA, voffA);
            PG8_WAIT_L(8); PG8_BAR; PG8_WAIT_L(0); PG8_MMA(0, 0, At, B0); PG8_BAR; PG8_SCHED;
            PG8_LDB(B1, 1, 1); PG8_STAGE(PG8_SB(1, 0), b3, voffB);
            PG8_BAR; PG8_WAIT_L(0); PG8_MMA(0, 1, At, B1); PG8_BAR;
            PG8_LDA(At, 1, 1); PG8_STAGE(PG8_SA(1, 0), a3, voffA);
            PG8_BAR; PG8_WAIT_L(0); PG8_MMA(1, 0, At, B0); PG8_BAR; PG8_SCHED;
            PG8_STAGE(PG8_SB(1, 1), b3 + hstepB, voffB);
            PG8_WAIT_V(6); PG8_BAR; PG8_MMA(1, 1, At, B1); PG8_BAR;
            }
        }
        if constexpr (ALIGN_EPI) { if (wr == 0) PG8_BAR; }
        if constexpr (!Epi::AFTER_DRAIN) { E(acc, cur, wr, wc, fr, fq); S.done(cur); }
        if (!has_next) break;
#pragma unroll
        for (int a = 0; a < 2; ++a)
#pragma unroll
            for (int b = 0; b < 2; ++b)
#pragma unroll
                for (int m = 0; m < 4; ++m)
#pragma unroll
                    for (int n = 0; n < 2; ++n) acc[a][b][m][n] = (f32x4){0.f, 0.f, 0.f, 0.f};
        cur = nxt; cA = nA; cB = nB; ++ui;
        if constexpr (ALIGN_EPI) { if (wr == 1) PG8_BAR; }
    }
    PG8_WAIT_V(0);
    if constexpr (!ALIGN_EPI) { if (wr == 0) PG8_BAR; }
    PG8_BAR;
    if constexpr (Epi::AFTER_DRAIN) { E.fused(acc, cur, wr, wc, fr, fq, lds, wid, lane); S.done(cur); }
#undef PG8_SA
#undef PG8_SB
#undef PG8_STAGE
#undef PG8_LDA
#undef PG8_LDB
#undef PG8_MMA
#undef PG8_WAIT_V
#undef PG8_WAIT_L
#undef PG8_BAR
#undef PG8_SCHED
}
}
namespace pg8 {
#define EPI_FOR_ROWS _Pragma("unroll") for (int ai = 0; ai < 2; ++ai) _Pragma("unroll") for (int m = 0; m < 4; ++m)
#define EPI_ROW (u.pm * BM + ai * HALF + wr * 64 + m * 16 + fr)
#define EPI_PK8(v0, v1) ((u32x4){cvt_pk_bf16((v0)[0], (v0)[1]), cvt_pk_bf16((v0)[2], (v0)[3]), cvt_pk_bf16((v1)[0], (v1)[1]), cvt_pk_bf16((v1)[2], (v1)[3])})

struct Epi1 {
    static constexpr bool PERM = true, AFTER_DRAIN = false;
    unsigned char* ws; const float* LB;
    __device__ __forceinline__ void operator()(const f32x4 (&acc)[2][2][4][2], const Unit& u, int wr, int wc, int fr, int fq) const {
        const int kind = u.pn >> 2, colt = (u.pn & 3) * BM + wc * 32 + 8 * fq;
        if (kind == 1) {
            f32x4 lb0[2], lb1[2];
#pragma unroll
            for (int bj = 0; bj < 2; ++bj) { lb0[bj] = *(const f32x4*)(LB + colt + bj * HALF); lb1[bj] = *(const f32x4*)(LB + colt + bj * HALF + 4); }
            EPI_FOR_ROWS { const int row = EPI_ROW;
#pragma unroll
                for (int bj = 0; bj < 2; ++bj) { f32x4 v0 = acc[ai][bj][m][0], v1 = acc[ai][bj][m][1];
#pragma unroll
                    for (int j = 0; j < 4; ++j) { v0[j] = __logf(lb0[bj][j] + (1.f - lb0[bj][j]) * sigm_f(v0[j])); v1[j] = __logf(lb1[bj][j] + (1.f - lb1[bj][j]) * sigm_f(v1[j])); }
                    float* p = (float*)(ws + WS_LF) + (size_t)row * WA + colt + bj * HALF; *(f32x4*)p = v0; *(f32x4*)(p + 4) = v1; } }
        } else if (kind == 4) {
            EPI_FOR_ROWS { const int row = EPI_ROW;
#pragma unroll
                for (int bj = 0; bj < 2; ++bj) { const int col = colt + bj * HALF; const u32x4 w = EPI_PK8(acc[ai][bj][m][0], acc[ai][bj][m][1]);
                    if (row < NPROMPT) *(u32x4*)((bf16_t*)(ws + WS_UG) + ((size_t)((col >> 4) * 256 + (row >> 5)) * 640 + (row & 31) * 16 + (col & 15))) = w;
                    else *(u32x4*)((bf16_t*)(ws + WS_US) + (size_t)(row - NPROMPT) * WA + col) = w; } }
        } else {
            const size_t ooff = kind == 0 ? WS_QB : (kind == 2 ? WS_VB : WS_GB); bf16_t* O = (bf16_t*)(ws + ooff);
            EPI_FOR_ROWS { const int row = EPI_ROW;
#pragma unroll
                for (int bj = 0; bj < 2; ++bj) { f32x4 v0 = acc[ai][bj][m][0], v1 = acc[ai][bj][m][1];
                    if (kind != 2) {
#pragma unroll
                        for (int j = 0; j < 4; ++j) { v0[j] = silu_f(v0[j]); v1[j] = silu_f(v1[j]); } }
                    *(u32x4*)(O + (size_t)row * WA + colt + bj * HALF) = EPI_PK8(v0, v1); } }
        }
    }
};
struct EpiS1 {
    static constexpr bool PERM = false, AFTER_DRAIN = false;
    float* XLOC;
    __device__ __forceinline__ void operator()(const f32x4 (&acc)[2][2][4][2], const Unit& u, int wr, int wc, int fr, int fq) const {
        EPI_FOR_ROWS { const int row = EPI_ROW;
#pragma unroll
            for (int n = 0; n < 2; ++n) *(f32x4*)(XLOC + ((size_t)u.z * 256 + row) * 128 + wc * 32 + n * 16 + 4 * fq) = acc[ai][0][m][n]; }
    }
};
struct EpiS2 {
    static constexpr bool PERM = true, AFTER_DRAIN = false;
    bf16_t* YBUF;
    __device__ __forceinline__ void operator()(const f32x4 (&acc)[2][2][4][2], const Unit& u, int wr, int wc, int fr, int fq) const {
        EPI_FOR_ROWS { const int row = EPI_ROW;
#pragma unroll
            for (int bj = 0; bj < 2; ++bj) { const int n8 = u.pn * BM + bj * HALF + wc * 32 + 8 * fq; f32x4 v0 = acc[ai][bj][m][0], v1 = acc[ai][bj][m][1];
#pragma unroll
                for (int j = 0; j < 4; ++j) { v0[j] = gelu_tanh_f(v0[j]); v1[j] = gelu_tanh_f(v1[j]); }
                *(u32x4*)(YBUF + ((size_t)row * 32 + (n8 >> 4)) * WA + u.z * 16 + (n8 & 15)) = EPI_PK8(v0, v1); } }
    }
};
struct EpiGlu {
    static constexpr bool PERM = true, AFTER_DRAIN = false;
    const bf16_t* YBUF; const float* gb; bf16_t* MIX;
    __device__ __forceinline__ void operator()(const f32x4 (&acc)[2][2][4][2], const Unit& u, int wr, int wc, int fr, int fq) const {
        const int colt = u.pn * BM + wc * 32 + 8 * fq;
        f32x4 b0[2], b1[2];
#pragma unroll
        for (int bj = 0; bj < 2; ++bj) { b0[bj] = *(const f32x4*)(gb + colt + bj * HALF); b1[bj] = *(const f32x4*)(gb + colt + bj * HALF + 4); }
        EPI_FOR_ROWS { const int row = EPI_ROW;
#pragma unroll
            for (int bj = 0; bj < 2; ++bj) { const int col = colt + bj * HALF; const u32x4 yw = *(const u32x4*)(YBUF + (size_t)row * WA + col);
                const f32x4 z0 = acc[ai][bj][m][0] + b0[bj], z1 = acc[ai][bj][m][1] + b1[bj]; f32x4 v0, v1;
                v0[0] = bf_lo(yw[0]) * sigm_f(z0[0]); v0[1] = bf_hi(yw[0]) * sigm_f(z0[1]); v0[2] = bf_lo(yw[1]) * sigm_f(z0[2]); v0[3] = bf_hi(yw[1]) * sigm_f(z0[3]);
                v1[0] = bf_lo(yw[2]) * sigm_f(z1[0]); v1[1] = bf_hi(yw[2]) * sigm_f(z1[1]); v1[2] = bf_lo(yw[3]) * sigm_f(z1[2]); v1[3] = bf_hi(yw[3]) * sigm_f(z1[3]);
                *(u32x4*)(MIX + (size_t)row * DM + WA + col) = EPI_PK8(v0, v1); } }
    }
};
struct EpiOut {
    static constexpr bool PERM = true, AFTER_DRAIN = false;
    const float *xp, *xs; float* X1; bf16_t* A2; float* SS2;
    __device__ __forceinline__ void operator()(const f32x4 (&acc)[2][2][4][2], const Unit& u, int wr, int wc, int fr, int fq) const {
        const int colt = u.pn * BM + wc * 32 + 8 * fq;
        EPI_FOR_ROWS { const int row = EPI_ROW;
            const float* xr = row < NPROMPT ? xp + (size_t)row * DM : xs + (size_t)(row - NPROMPT) * DM; float ss = 0.f;
#pragma unroll
            for (int bj = 0; bj < 2; ++bj) { const int col = colt + bj * HALF; const f32x4 v0 = acc[ai][bj][m][0] + *(const f32x4*)(xr + col), v1 = acc[ai][bj][m][1] + *(const f32x4*)(xr + col + 4);
                *(f32x4*)(X1 + (size_t)row * DM + col) = v0; *(f32x4*)(X1 + (size_t)row * DM + col + 4) = v1;
                *(u32x4*)(A2 + (size_t)row * DM + col) = EPI_PK8(v0, v1);
                ss += (v0[0] * v0[0] + v0[1] * v0[1]) + (v0[2] * v0[2] + v0[3] * v0[3]) + (v1[0] * v1[0] + v1[1] * v1[1]) + (v1[2] * v1[2] + v1[3] * v1[3]); }
            ss += __shfl_xor(ss, 16); ss += __shfl_xor(ss, 32);
            if (fq == 0) atomicAdd(SS2 + row, ss); }
    }
};
struct EpiUp {
    static constexpr bool PERM = true, AFTER_DRAIN = false;
    const float* SS2; bf16_t* H;
    __device__ __forceinline__ void operator()(const f32x4 (&acc)[2][2][4][2], const Unit& u, int wr, int wc, int fr, int fq) const {
        const int colt = u.pn * BM + wc * 32 + 8 * fq;
        EPI_FOR_ROWS { const int row = EPI_ROW;
            const float rs = rsqrtf(SS2[row] * (1.f / DM) + 1e-6f);
#pragma unroll
            for (int bj = 0; bj < 2; ++bj) { f32x4 v0 = acc[ai][bj][m][0] * rs, v1 = acc[ai][bj][m][1] * rs;
#pragma unroll
                for (int j = 0; j < 4; ++j) { const float a = fmaxf(v0[j], 0.f), b = fmaxf(v1[j], 0.f); v0[j] = a * a; v1[j] = b * b; }
                *(u32x4*)(H + (size_t)row * DFF + colt + bj * HALF) = EPI_PK8(v0, v1); } }
    }
};
struct EpiDown {
    static constexpr bool PERM = true, AFTER_DRAIN = false;
    bf16_t* PART;
    __device__ __forceinline__ void operator()(const f32x4 (&acc)[2][2][4][2], const Unit& u, int wr, int wc, int fr, int fq) const {
        const int colt = u.pn * BM + wc * 32 + 8 * fq;
        EPI_FOR_ROWS { const int row = EPI_ROW;
#pragma unroll
            for (int bj = 0; bj < 2; ++bj) *(u32x4*)(PART + ((size_t)u.z * NTOK + row) * DM + colt + bj * HALF) = EPI_PK8(acc[ai][bj][m][0], acc[ai][bj][m][1]); }
    }
};
}
constexpr int TR_WAVE_LDS = 64 * 65 * 4;
__device__ __forceinline__ void transpose_item(const float* W, int K, int N, bf16_t* WT, LAS float* scr, int item, int lane, const float* kscale) {
    const int nblk = N / 64, kb = item / nblk, nb = item % nblk, k0 = 64 * kb, n0 = 64 * nb, kr = lane >> 4, n4 = (lane & 15) * 4;
    f32x4 v[16];
#pragma unroll
    for (int i = 0; i < 16; ++i) v[i] = *(const f32x4*)(W + (size_t)(k0 + 4 * i + kr) * N + n0 + n4);
#pragma unroll
    for (int i = 0; i < 16; ++i) { const int k = 4 * i + kr; f32x4 x = v[i]; if (kscale) x = x * kscale[k0 + k]; LAS float* d = scr + k * 65 + n4; d[0] = x[0]; d[1] = x[1]; d[2] = x[2]; d[3] = x[3]; }
    LDS_WAIT();
    const int c = lane & 7;
#pragma unroll
    for (int j = 0; j < 8; ++j) { const int n = (lane >> 3) + 8 * j; const LAS float* s = scr + (8 * c) * 65 + n;
        u32x4 o; o.x = cvt_pk_bf16(s[0 * 65], s[1 * 65]); o.y = cvt_pk_bf16(s[2 * 65], s[3 * 65]); o.z = cvt_pk_bf16(s[4 * 65], s[5 * 65]); o.w = cvt_pk_bf16(s[6 * 65], s[7 * 65]);
        *(u32x4*)(WT + (size_t)(n0 + n) * K + k0 + 8 * c) = o; }
    LDS_WAIT();
}
__device__ __forceinline__ void rms_row_bf16(const float* xrow, const float* g, bf16_t* orow, int lane) {
    const f32x4* xr = (const f32x4*)xrow + lane; f32x4 v[8]; float s = 0.f;
#pragma unroll
    for (int j = 0; j < 8; ++j) { v[j] = xr[64 * j]; s += (v[j][0] * v[j][0] + v[j][1] * v[j][1]) + (v[j][2] * v[j][2] + v[j][3] * v[j][3]); }
    const float rstd = rsqrtf(wave_sum(s) * (1.f / DM) + 1e-6f);
    const f32x4* gr = (const f32x4*)g + lane; u32x2* o8 = (u32x2*)orow + lane;
#pragma unroll
    for (int j = 0; j < 8; ++j) { const f32x4 gv = gr[64 * j]; o8[64 * j] = (u32x2){cvt_pk_bf16(v[j][0] * rstd * gv[0], v[j][1] * rstd * gv[1]), cvt_pk_bf16(v[j][2] * rstd * gv[2], v[j][3] * rstd * gv[3])}; }
}

__device__ __forceinline__ void s5_table_item(int g, int q, const float* a_re, const float* a_im, const float* b_re, const float* b_im, const float* c_re, const float* c_im, const float* dd, const float* log_step,
                                              bf16_t* TB, bf16_t* GT, float* LAMT, float* BBT, LAS float* L, int tid) {
    LAS float* LAMR = L; LAS float* LAMI = L + 2112; LAS float* BBR = L + 4224; LAS float* BBI = L + 5248; LAS float* CR = L + 6272; LAS float* CI = L + 7296; LAS float* KQ = L + 8320;
    const float dt = __expf(log_step[g]);
    for (int idx = tid; idx < 2112; idx += 512) { const int j = idx >> 6, p = idx & 63; const float are = a_re[g * 64 + p], aim = a_im[g * 64 + p];
        const float mag = __expf((float)j * are * dt); const float rev = (float)j * (aim * dt) * 0.15915494309189535f; const float fr = rev - rintf(rev);
        LAMR[idx] = mag * cosf(fr * 6.283185307179586f); LAMI[idx] = mag * sinf(fr * 6.283185307179586f); }
    for (int idx = tid; idx < 1024; idx += 512) { const int p = idx >> 4; const float are = a_re[g * 64 + p], aim = a_im[g * 64 + p];
        const float mag = __expf(are * dt); const float rev = (aim * dt) * 0.15915494309189535f; const float fr = rev - rintf(rev);
        const float lr = mag * cosf(fr * 6.283185307179586f), li = mag * sinf(fr * 6.283185307179586f);
        const float den = are * are + aim * aim, nr = lr - 1.f, ni = li, rr = (nr * are + ni * aim) / den, ri = (ni * are - nr * aim) / den;
        const float br = b_re[g * 1024 + idx], bi = b_im[g * 1024 + idx]; BBR[idx] = rr * br - ri * bi; BBI[idx] = rr * bi + ri * br;
        CR[idx] = c_re[g * 1024 + idx]; CI[idx] = c_im[g * 1024 + idx]; }
    __syncthreads();
    {
        const int cc = tid & 255, jh = tid >> 8, c = cc >> 4, c1 = cc & 15; float a4[4] = {0.f, 0.f, 0.f, 0.f};
        for (int p = 0; p < 64; ++p) { const float cr = CR[c * 64 + p], ci = CI[c * 64 + p], br = BBR[p * 16 + c1], bi = BBI[p * 16 + c1]; const float cbr = cr * br - ci * bi, cbi = cr * bi + ci * br;
#pragma unroll
            for (int e = 0; e < 4; ++e) { const int j = 8 * q + 4 * jh + e; a4[e] += LAMR[j * 64 + p] * cbr - LAMI[j * 64 + p] * cbi; } }
#pragma unroll
        for (int e = 0; e < 4; ++e) { const int j = 8 * q + 4 * jh + e; KQ[(4 * jh + e) * 256 + cc] = a4[e] + ((j == 0 && c == c1) ? dd[g * 16 + c] : 0.f); }
    }
    __syncthreads();
    bf16_t* TBg = TB + (size_t)g * 512 * 640;
    for (int idx = tid; idx < 4096; idx += 512) {
        const int jl = idx >> 9, t = (idx >> 4) & 31, c = idx & 15, j = 8 * q + jl;
        if (t >= j) { const LAS float* k = KQ + jl * 256 + c * 16; u32x4 w0, w1;
            w0.x = cvt_pk_bf16(k[0], k[1]); w0.y = cvt_pk_bf16(k[2], k[3]); w0.z = cvt_pk_bf16(k[4], k[5]); w0.w = cvt_pk_bf16(k[6], k[7]);
            w1.x = cvt_pk_bf16(k[8], k[9]); w1.y = cvt_pk_bf16(k[10], k[11]); w1.z = cvt_pk_bf16(k[12], k[13]); w1.w = cvt_pk_bf16(k[14], k[15]);
            u32x4* d = (u32x4*)(TBg + (size_t)(t * 16 + c) * 640 + (t - j) * 16); d[0] = w0; d[1] = w1; } }
    for (int idx = tid; idx < 4096; idx += 512) {
        const int tl = idx >> 9, c = (idx >> 5) & 15, s = idx & 31, t = 8 * q + tl;
        if (s > t) { u32x4* d = (u32x4*)(TBg + (size_t)(t * 16 + c) * 640 + s * 16); d[0] = (u32x4){0u, 0u, 0u, 0u}; d[1] = (u32x4){0u, 0u, 0u, 0u}; } }
    for (int idx = tid; idx < 16384; idx += 512) {
        const int p = idx & 63, ri = (idx >> 6) & 1, c = (idx >> 7) & 15, tl = idx >> 11, t = 8 * q + tl;
        const float lr = LAMR[(t + 1) * 64 + p], li = LAMI[(t + 1) * 64 + p], cr = CR[c * 64 + p], ci = CI[c * 64 + p];
        const float val = ri == 0 ? (cr * lr - ci * li) : -(cr * li + ci * lr);
        TBg[(size_t)(t * 16 + c) * 640 + 512 + ri * 64 + p] = f2bf(val); }
    bf16_t* GTg = GT + (size_t)g * 256 * 512;
    for (int idx = tid; idx < 16384; idx += 512) {
        const int sc = idx & 511, s = sc >> 4, c1 = sc & 15, r = 32 * q + (idx >> 9), ri = r >> 6, p = r & 63;
        const float lr = LAMR[(31 - s) * 64 + p], li = LAMI[(31 - s) * 64 + p], br = BBR[p * 16 + c1], bi = BBI[p * 16 + c1];
        GTg[(size_t)r * 512 + sc] = f2bf(ri == 0 ? (lr * br - li * bi) : (lr * bi + li * br)); }
    for (int idx = tid; idx < 2048; idx += 512) {
        ((u32x4*)(GTg + (size_t)(128 + 32 * q) * 512))[idx] = (u32x4){0u, 0u, 0u, 0u}; }
    if (q == 0) {
        if (tid < 64) { f32x4 v; v[0] = LAMR[64 + tid]; v[1] = LAMI[64 + tid]; v[2] = LAMR[32 * 64 + tid]; v[3] = LAMI[32 * 64 + tid]; *(f32x4*)(LAMT + (size_t)(g * 64 + tid) * 4) = v; }
        for (int idx = tid; idx < 1024; idx += 512) { *(f32x2*)(BBT + ((size_t)g * 1024 + idx) * 2) = (f32x2){BBR[idx], BBI[idx]}; }
    }
    __syncthreads();
}

__device__ __forceinline__ void hgrn_pre_load(int item, const float* LF, const bf16_t* QB, const bf16_t* VB, float (&lf)[16], bf16_t (&qv)[16], bf16_t (&vv)[16], int tid) {
    const int bh = item >> 5, c = item & 31, b = bh >> 3, h = bh & 7, seg = tid >> 7, k = tid & 127;
    const size_t base = (size_t)(b * 2048 + c * 64 + seg * 16) * WA + h * 128 + k;
#pragma unroll
    for (int i = 0; i < 16; ++i) { lf[i] = LF[base + (size_t)i * WA]; qv[i] = QB[base + (size_t)i * WA]; vv[i] = VB[base + (size_t)i * WA]; }
}
__device__ __forceinline__ void hgrn_pre_compute(int item, const float (&lf)[16], const bf16_t (&qv)[16], const bf16_t (&vv)[16], bf16_t* PRE, float* DL, LAS float* tot, int tid) {
    const int seg = tid >> 7, k = tid & 127;
    float pl[16]; float run = 0.f;
#pragma unroll
    for (int i = 0; i < 16; ++i) { run += lf[i]; pl[i] = run; }
    tot[seg * 128 + k] = run;
    __syncthreads();
    float off = 0.f, bl = 0.f;
#pragma unroll
    for (int s = 0; s < 4; ++s) { const float t = tot[s * 128 + k]; if (s < seg) off += t; bl += t; }
    __syncthreads();
    bf16_t* P = PRE + (size_t)item * 32768;
    float kh[16];
#pragma unroll
    for (int i = 0; i < 16; ++i) { const float bc = pl[i] + off, kk = 1.f - __expf(lf[i]);
        P[(seg * 16 + i) * 128 + k] = f2bf(bf2f(qv[i]) * __expf(bc)); P[8192 + (seg * 16 + i) * 128 + k] = f2bf(kk * __expf(-bc)); kh[i] = kk * __expf(bl - bc); }
    u32x4 w0, w1;
    w0.x = cvt_pk_bf16(kh[0], kh[1]); w0.y = cvt_pk_bf16(kh[2], kh[3]); w0.z = cvt_pk_bf16(kh[4], kh[5]); w0.w = cvt_pk_bf16(kh[6], kh[7]);
    w1.x = cvt_pk_bf16(kh[8], kh[9]); w1.y = cvt_pk_bf16(kh[10], kh[11]); w1.z = cvt_pk_bf16(kh[12], kh[13]); w1.w = cvt_pk_bf16(kh[14], kh[15]);
    { u32x4* d = (u32x4*)(P + 16384 + k * 64 + seg * 16); d[0] = w0; d[1] = w1; }
    w0.x = (unsigned)vv[0] | ((unsigned)vv[1] << 16); w0.y = (unsigned)vv[2] | ((unsigned)vv[3] << 16); w0.z = (unsigned)vv[4] | ((unsigned)vv[5] << 16); w0.w = (unsigned)vv[6] | ((unsigned)vv[7] << 16);
    w1.x = (unsigned)vv[8] | ((unsigned)vv[9] << 16); w1.y = (unsigned)vv[10] | ((unsigned)vv[11] << 16); w1.z = (unsigned)vv[12] | ((unsigned)vv[13] << 16); w1.w = (unsigned)vv[14] | ((unsigned)vv[15] << 16);
    { u32x4* d = (u32x4*)(P + 24576 + k * 64 + seg * 16); d[0] = w0; d[1] = w1; }
    if (seg == 0) DL[(size_t)item * 128 + k] = __expf(bl);
}

constexpr int CH_QT = 0, CH_KT = 17408, CH_KH = 34816, CH_VT = 53248, CH_P = 71680, CH_ST = 80896, CH_DL = 115712;
__device__ __forceinline__ bf16x8 ldfrag(const LAS unsigned char* base, int row, int stride, int kb) { return *(const LAS bf16x8*)(base + row * stride + kb); }
__device__ __forceinline__ void hgrn_chain(int b, int h, const bf16_t* PRE, const float* DL, float* ORAW, float* out_state, LAS unsigned char* lds, int tid) {
    const int lane = tid & 63, w = __builtin_amdgcn_readfirstlane(tid >> 6), l15 = lane & 15, lq = lane >> 4;
    f32x4 sacc[8];
#pragma unroll
    for (int i = 0; i < 8; ++i) sacc[i] = (f32x4){0.f, 0.f, 0.f, 0.f};
    for (int i = tid; i < 34816 / 16; i += 512) ((LAS u32x4*)(lds + CH_ST))[i] = (u32x4){0u, 0u, 0u, 0u};
    const int item0 = (b * 8 + h) * 32;
    u32x4 pf[8]; float dlv = 0.f;
    {   const u32x4* src = (const u32x4*)(PRE + (size_t)item0 * 32768);
#pragma unroll
        for (int j = 0; j < 8; ++j) pf[j] = src[tid + 512 * j];
        if (tid < 128) dlv = DL[(size_t)item0 * 128 + tid]; }
    for (int c = 0; c < 32; ++c) {
#pragma unroll
        for (int j = 0; j < 8; ++j) { const int pi = (tid + 512 * j) & 1023; int off;
            if (j < 2) off = CH_QT + (pi >> 4) * 272 + (pi & 15) * 16; else if (j < 4) off = CH_KT + (pi >> 4) * 272 + (pi & 15) * 16;
            else if (j < 6) off = CH_KH + (pi >> 3) * 144 + (pi & 7) * 16; else off = CH_VT + (pi >> 3) * 144 + (pi & 7) * 16;
            *(LAS u32x4*)(lds + off) = pf[j]; }
        if (tid < 128) ((LAS float*)(lds + CH_DL))[tid] = dlv;
        __syncthreads();
        if (c + 1 < 32) { const u32x4* src = (const u32x4*)(PRE + (size_t)(item0 + c + 1) * 32768);
#pragma unroll
            for (int j = 0; j < 8; ++j) pf[j] = src[tid + 512 * j];
            if (tid < 128) dlv = DL[(size_t)(item0 + c + 1) * 128 + tid]; }
        { const int tt = w >> 1;
#pragma unroll
          for (int e = 0; e < 2; ++e) { const int st = (w & 1) * 2 + e; f32x4 a = (f32x4){0.f, 0.f, 0.f, 0.f};
#pragma unroll
            for (int ks = 0; ks < 4; ++ks) a = __builtin_amdgcn_mfma_f32_16x16x32_bf16(ldfrag(lds + CH_KT, 16 * st + l15, 272, (ks * 32 + 8 * lq) * 2), ldfrag(lds + CH_QT, 16 * tt + l15, 272, (ks * 32 + 8 * lq) * 2), a, 0, 0, 0);
            const int t = 16 * tt + l15, s0 = 16 * st + 4 * lq;
#pragma unroll
            for (int j = 0; j < 4; ++j) a[j] = (s0 + j <= t) ? a[j] : 0.f;
            *(LAS u32x2*)(lds + CH_P + t * 144 + s0 * 2) = (u32x2){cvt_pk_bf16(a[0], a[1]), cvt_pk_bf16(a[2], a[3])}; } }
        __syncthreads();
        bf16x8 aV[2], aS[4];
#pragma unroll
        for (int ss = 0; ss < 2; ++ss) aV[ss] = ldfrag(lds + CH_VT, 16 * w + l15, 144, (ss * 32 + 8 * lq) * 2);
#pragma unroll
        for (int ks = 0; ks < 4; ++ks) aS[ks] = ldfrag(lds + CH_ST, 16 * w + l15, 272, (ks * 32 + 8 * lq) * 2);
        const int tok0 = b * 2048 + c * 64;
#pragma unroll
        for (int tt = 0; tt < 4; ++tt) { f32x4 a = (f32x4){0.f, 0.f, 0.f, 0.f};
#pragma unroll
            for (int ss = 0; ss < 2; ++ss) a = __builtin_amdgcn_mfma_f32_16x16x32_bf16(aV[ss], ldfrag(lds + CH_P, 16 * tt + l15, 144, (ss * 32 + 8 * lq) * 2), a, 0, 0, 0);
#pragma unroll
            for (int ks = 0; ks < 4; ++ks) a = __builtin_amdgcn_mfma_f32_16x16x32_bf16(aS[ks], ldfrag(lds + CH_QT, 16 * tt + l15, 272, (ks * 32 + 8 * lq) * 2), a, 0, 0, 0);
            *(f32x4*)(ORAW + (size_t)(tok0 + 16 * tt + l15) * WA + h * 128 + 16 * w + 4 * lq) = a; }
#pragma unroll
        for (int kt = 0; kt < 8; ++kt) { const f32x4 d4 = *(const LAS f32x4*)(lds + CH_DL + (16 * kt + 4 * lq) * 4); sacc[kt] = sacc[kt] * d4;
#pragma unroll
            for (int ss = 0; ss < 2; ++ss) sacc[kt] = __builtin_amdgcn_mfma_f32_16x16x32_bf16(ldfrag(lds + CH_KH, 16 * kt + l15, 144, (ss * 32 + 8 * lq) * 2), aV[ss], sacc[kt], 0, 0, 0); }
        __syncthreads();
#pragma unroll
        for (int kt = 0; kt < 8; ++kt) *(LAS u32x2*)(lds + CH_ST + (16 * w + l15) * 272 + (16 * kt + 4 * lq) * 2) = (u32x2){cvt_pk_bf16(sacc[kt][0], sacc[kt][1]), cvt_pk_bf16(sacc[kt][2], sacc[kt][3])};
    }
    if (out_state) {
#pragma unroll
    for (int kt = 0; kt < 8; ++kt)
#pragma unroll
        for (int j = 0; j < 4; ++j) out_state[((size_t)(b * 8 + h) * 128 + 16 * kt + 4 * lq + j) * 128 + 16 * w + l15] = sacc[kt][j]; }
    __syncthreads();
}

__device__ __forceinline__ void hgrn_sample_item(int bh, const float* LF, const bf16_t* QB, const bf16_t* VB, const float* s0, float* ORAWS, float* out_state, LAS float* L, int tid) {
    const int b = bh >> 3, h = bh & 7, v4 = tid & 31, kr = tid >> 5;
    { const int t = tid >> 7, k = tid & 127; const size_t rb = (size_t)(NPROMPT + b * 4 + t) * WA + h * 128 + k;
      const float f = __expf(LF[rb]); L[(t * 3 + 0) * 128 + k] = f; L[(t * 3 + 1) * 128 + k] = 1.f - f; L[(t * 3 + 2) * 128 + k] = bf2f(QB[rb]); L[1536 + t * 128 + k] = bf2f(VB[rb]); }
    f32x4 S[8];
#pragma unroll
    for (int i = 0; i < 8; ++i) S[i] = *(const f32x4*)(s0 + ((size_t)bh * 128 + kr + 16 * i) * 128 + 4 * v4);
    __syncthreads();
#pragma unroll
    for (int t = 0; t < 4; ++t) {
        const f32x4 vv = *(const LAS f32x4*)(L + 1536 + t * 128 + 4 * v4); f32x4 po = (f32x4){0.f, 0.f, 0.f, 0.f};
#pragma unroll
        for (int i = 0; i < 8; ++i) { const int k = kr + 16 * i; const float f = L[(t * 3 + 0) * 128 + k], kk = L[(t * 3 + 1) * 128 + k], q = L[(t * 3 + 2) * 128 + k];
            S[i] = S[i] * f + vv * kk; po += S[i] * q; }
        *(LAS f32x4*)(L + 2048 + (t * 16 + kr) * 128 + 4 * v4) = po;
    }
    __syncthreads();
    { const int t = tid >> 7, v = tid & 127; float s = 0.f;
#pragma unroll
      for (int j = 0; j < 16; ++j) s += L[2048 + (t * 16 + j) * 128 + v];
      ORAWS[(size_t)(b * 4 + t) * WA + h * 128 + v] = s; }
    if (out_state) {
#pragma unroll
    for (int i = 0; i < 8; ++i) *(f32x4*)(out_state + ((size_t)bh * 128 + kr + 16 * i) * 128 + 4 * v4) = S[i]; }
    __syncthreads();
}

__device__ __forceinline__ void s5_scan(int g, const float* XLOC, const float* LAMT, bf16_t* UG, float* o_rp, float* o_ip, int tid) {
    if (tid < 256) { const int b = tid >> 6, p = tid & 63; const f32x4 lm = *(const f32x4*)(LAMT + (size_t)(g * 64 + p) * 4); const float l32r = lm[2], l32i = lm[3];
        float cr = 0.f, ci = 0.f;
        for (int cb = 0; cb < 4; ++cb) { float xr[16], xi[16];
#pragma unroll
            for (int i = 0; i < 16; ++i) { const size_t row = (size_t)g * 256 + b * 64 + cb * 16 + i; xr[i] = XLOC[row * 128 + p]; xi[i] = XLOC[row * 128 + 64 + p]; }
#pragma unroll
            for (int i = 0; i < 16; ++i) { const size_t row = (size_t)g * 256 + b * 64 + cb * 16 + i;
                UG[row * 640 + 512 + p] = f2bf(cr); UG[row * 640 + 576 + p] = f2bf(ci);
                const float nr = l32r * cr - l32i * ci + xr[i], ni = l32r * ci + l32i * cr + xi[i]; cr = nr; ci = ni; } }
        if (o_rp) o_rp[(size_t)(b * 64 + g) * 64 + p] = cr; if (o_ip) o_ip[(size_t)(b * 64 + g) * 64 + p] = ci; }
    __threadfence();
    __syncthreads();
}

__device__ __forceinline__ void s5_sample_item(int item, const bf16_t* US, const float* LAMT, const float* BBT, const float* c_re, const float* c_im, const float* dd, const float* x0r, const float* x0i,
                                               bf16_t* YBUF, float* o_rs, float* o_is, LAS float* L, int tid) {
    const int g = item >> 4, b = (item & 15) * 8 + (tid >> 6), lane = tid & 63, wv = tid >> 6;
    LAS float* CRs = L; LAS float* CIs = L + 16 * 65; LAS float* XS = L + 2 * 16 * 65 + wv * 512;
    for (int idx = tid; idx < 1024; idx += 512) { const int c = idx >> 6, p = idx & 63; CRs[c * 65 + p] = c_re[g * 1024 + idx]; CIs[c * 65 + p] = c_im[g * 1024 + idx]; }
    const f32x4 lm = *(const f32x4*)(LAMT + (size_t)(g * 64 + lane) * 4);
    float xr = x0r[(size_t)(b * 64 + g) * 64 + lane], xi = x0i[(size_t)(b * 64 + g) * 64 + lane];
    float bbr[16], bbi[16];
#pragma unroll
    for (int c = 0; c < 16; c += 2) { const f32x4 v = *(const f32x4*)(BBT + ((size_t)(g * 64 + lane) * 16 + c) * 2); bbr[c] = v[0]; bbi[c] = v[1]; bbr[c + 1] = v[2]; bbi[c + 1] = v[3]; }
    float myu = 0.f;
#pragma unroll
    for (int t = 0; t < 4; ++t) {
        const u32x4* up = (const u32x4*)(US + (size_t)(b * 4 + t) * WA + g * 16); const u32x4 u0 = up[0], u1 = up[1];
        const float u[16] = {bf_lo(u0.x), bf_hi(u0.x), bf_lo(u0.y), bf_hi(u0.y), bf_lo(u0.z), bf_hi(u0.z), bf_lo(u0.w), bf_hi(u0.w), bf_lo(u1.x), bf_hi(u1.x), bf_lo(u1.y), bf_hi(u1.y), bf_lo(u1.z), bf_hi(u1.z), bf_lo(u1.w), bf_hi(u1.w)};
        float br = 0.f, bi = 0.f;
#pragma unroll
        for (int c = 0; c < 16; ++c) { br += bbr[c] * u[c]; bi += bbi[c] * u[c]; if ((lane >> 4) == t && (lane & 15) == c) myu = u[c]; }
        const float nr = lm[0] * xr - lm[1] * xi + br, ni = lm[0] * xi + lm[1] * xr + bi; xr = nr; xi = ni;
        XS[(t * 2 + 0) * 64 + lane] = xr; XS[(t * 2 + 1) * 64 + lane] = xi;
    }
    if (o_rs) o_rs[(size_t)(b * 64 + g) * 64 + lane] = xr; if (o_is) o_is[(size_t)(b * 64 + g) * 64 + lane] = xi;
    __syncthreads();
    { const int t = lane >> 4, c = lane & 15; float y = 0.f;
      for (int p = 0; p < 64; ++p) y += CRs[c * 65 + p] * XS[(t * 2) * 64 + p] - CIs[c * 65 + p] * XS[(t * 2 + 1) * 64 + p];
      y += dd[g * 16 + c] * myu;
      YBUF[(size_t)(NPROMPT + b * 4 + t) * WA + g * 16 + c] = f2bf(gelu_tanh_f(y)); }
    __syncthreads();
}

__device__ __forceinline__ void gate_row(int tok, const float* ORAW, const float* ORAWS, const bf16_t* GB, const float* ng, bf16_t* MIX, int lane) {
    const float* orow = tok < NPROMPT ? ORAW + (size_t)tok * WA : ORAWS + (size_t)(tok - NPROMPT) * WA;
    f32x4 v[4]; float s = 0.f;
#pragma unroll
    for (int j = 0; j < 4; ++j) { v[j] = ((const f32x4*)orow)[lane + 64 * j]; s += (v[j][0] * v[j][0] + v[j][1] * v[j][1]) + (v[j][2] * v[j][2] + v[j][3] * v[j][3]); }
    const float rstd = rsqrtf(wave_sum(s) * (1.f / WA) + 1e-6f);
#pragma unroll
    for (int j = 0; j < 4; ++j) { const f32x4 gv = ((const f32x4*)ng)[lane + 64 * j]; const u32x2 gw = ((const u32x2*)(GB + (size_t)tok * WA))[lane + 64 * j];
        ((u32x2*)(MIX + (size_t)tok * DM))[lane + 64 * j] = (u32x2){cvt_pk_bf16(v[j][0] * rstd * gv[0] * bf_lo(gw.x), v[j][1] * rstd * gv[1] * bf_hi(gw.x)), cvt_pk_bf16(v[j][2] * rstd * gv[2] * bf_lo(gw.y), v[j][3] * rstd * gv[3] * bf_hi(gw.y))}; }
}

__device__ __forceinline__ void final_row(int tok, float* X1, const bf16_t* PART, const float* gf, int lane) {
    f32x4* xr = (f32x4*)(X1 + (size_t)tok * DM); f32x4 v[8]; float s = 0.f;
#pragma unroll
    for (int j = 0; j < 8; ++j) { v[j] = xr[lane + 64 * j];
#pragma unroll
        for (int z = 0; z < 4; ++z) { const u32x2 pw = ((const u32x2*)(PART + ((size_t)z * NTOK + tok) * DM))[lane + 64 * j]; v[j][0] += bf_lo(pw.x); v[j][1] += bf_hi(pw.x); v[j][2] += bf_lo(pw.y); v[j][3] += bf_hi(pw.y); }
        s += (v[j][0] * v[j][0] + v[j][1] * v[j][1]) + (v[j][2] * v[j][2] + v[j][3] * v[j][3]); }
    const float rstd = rsqrtf(wave_sum(s) * (1.f / DM) + 1e-6f);
#pragma unroll
    for (int j = 0; j < 8; ++j) { const f32x4 gv = ((const f32x4*)gf)[lane + 64 * j]; xr[lane + 64 * j] = (f32x4){v[j][0] * rstd * gv[0], v[j][1] * rstd * gv[1], v[j][2] * rstd * gv[2], v[j][3] * rstd * gv[3]}; }
}
constexpr int LDS_BYTES = 147456, NPH = 9;
struct Args { const float* in[24]; float* out; unsigned char* ws; int ph_lo, ph_hi, coop, omask; };

__global__ void __launch_bounds__(512, 2) mk(Args a) {
    extern __shared__ __attribute__((aligned(16))) unsigned char lds_raw[];
    LAS unsigned char* lds = (LAS unsigned char*)lds_raw;
    cg::grid_group grid = cg::this_grid();
    const int tid = threadIdx.x, lane = tid & 63, wave = __builtin_amdgcn_readfirstlane(tid >> 6), G = gridDim.x, blk = blockIdx.x;
    const int gw = blk * 8 + wave, NGW = G * 8;
    unsigned char* ws = a.ws; float* out = a.out;
    const float *x_p = a.in[0], *x_s = a.in[1];
    bf16_t* UG = (bf16_t*)(ws + WS_UG); float* XLOC = (float*)(ws + WS_XLOC); bf16_t* US = (bf16_t*)(ws + WS_US); bf16_t* WTDOWN = (bf16_t*)(ws + WS_WTDOWN);
    bf16_t* HB = (bf16_t*)(ws + WS_HB); bf16_t* YBUF = (bf16_t*)(ws + WS_YBUF); bf16_t* QB = (bf16_t*)(ws + WS_QB); bf16_t* VB = (bf16_t*)(ws + WS_VB); bf16_t* GB = (bf16_t*)(ws + WS_GB);
    float* LF = (float*)(ws + WS_LF); float* ORAW = LF; bf16_t* WTGLU = (bf16_t*)(ws + WS_WTGLU); bf16_t* WTOUT = (bf16_t*)(ws + WS_WTOUT); bf16_t* HH = (bf16_t*)(ws + WS_H);
    bf16_t* WTIN = (bf16_t*)(ws + WS_WTIN); bf16_t* PRE = (bf16_t*)(ws + WS_PRE); bf16_t* WTUP = (bf16_t*)(ws + WS_WTUP); bf16_t* A2 = (bf16_t*)(ws + WS_A2); bf16_t* TB = (bf16_t*)(ws + WS_TB);
    bf16_t* MIX = (bf16_t*)(ws + WS_MIX); bf16_t* GT = (bf16_t*)(ws + WS_GT); bf16_t* PART = (bf16_t*)(ws + WS_PART);
    float* SS2 = (float*)(ws + WS_SS2); float* LB = (float*)(ws + WS_LB); float* LAMT = (float*)(ws + WS_LAMT); float* BBT = (float*)(ws + WS_BBT); float* DL = (float*)(ws + WS_DL); float* ORAWS = (float*)(ws + WS_ORAWS);
    float* X1 = out + O_YP;
    float* o_hp = (a.omask & 4) ? out + O_HP : nullptr; float* o_rp = (a.omask & 8) ? out + O_RP : nullptr; float* o_ip = (a.omask & 16) ? out + O_IP : nullptr;
    float* o_hs = (a.omask & 32) ? out + O_HS : nullptr; float* o_rs = (a.omask & 64) ? out + O_RS : nullptr; float* o_is = (a.omask & 128) ? out + O_IS : nullptr;
    const int lo = a.ph_lo, hi = a.ph_hi;
#define IN(k) (lo <= (k) && (k) < hi)
#define SEAM(k) do { if (IN(k) && IN((k) + 1) && a.coop) grid.sync(); } while (0)

    if (IN(0)) {
        for (int it = blk; it < 256; it += G) s5_table_item(it >> 2, it & 3, a.in[11], a.in[12], a.in[13], a.in[14], a.in[15], a.in[16], a.in[17], a.in[18], TB, GT, LAMT, BBT, (LAS float*)lds, tid);
        for (int i = blk * 512 + tid; i < NTOK; i += G * 512) SS2[i] = 0.f;
        for (int i = blk * 512 + tid; i < WA; i += G * 512) { const float e0 = __expf(a.in[9][i]), e1 = __expf(a.in[9][WA + i]); LB[i] = e0 / (e0 + e1); }
        LAS float* scr = (LAS float*)(lds + wave * TR_WAVE_LDS);
        constexpr int I_IN = (DM / 64) * (INC / 64), I_GLU = (WA / 64) * (WA / 64), I_OUT = (DM / 64) * (DM / 64);
        for (int it = gw; it < I_IN + I_GLU + I_OUT; it += NGW) {
            if (it < I_IN) transpose_item(a.in[5], DM, INC, WTIN, scr, it, lane, nullptr);
            else if (it < I_IN + I_GLU) transpose_item(a.in[19], WA, WA, WTGLU, scr, it - I_IN, lane, nullptr);
            else transpose_item(a.in[6], DM, DM, WTOUT, scr, it - I_IN - I_GLU, lane, nullptr);
        }
        for (int r = gw; r < NTOK; r += NGW) rms_row_bf16(r < NPROMPT ? x_p + (size_t)r * DM : x_s + (size_t)(r - NPROMPT) * DM, a.in[7], HB + (size_t)r * DM, lane);
        __syncthreads();
    }
    SEAM(0);
    if (IN(1)) {
        pg8::Gemm g{HB, WTIN, DM, DM, DM}; pg8::TileOrder S; S.init(NTOK, INC, 1, G, blk);
        pg8::Epi1 E{ws, LB};
        pg8::gemm_phase<pg8::Epi1, pg8::TileOrder, true, true>(lds, g, S, E);
    }
    SEAM(1);
    if (IN(2)) {
        { pg8::Gemm g{UG, GT, 512, 640, 512}; pg8::GroupOrder S{0, 64, 1, G, blk, (size_t)256 * 640, (size_t)256 * 512}; pg8::EpiS1 E{XLOC};
          pg8::gemm_phase<pg8::EpiS1, pg8::GroupOrder, true, true>(lds, g, S, E); }
        __syncthreads();
        {
            int it, step, last;
            if (G == 256) { if (blk >= 64) { it = blk - 64; step = 192; last = 960; } else { it = 960 + blk; step = 1024; last = 1024; } } else { it = blk; step = G; last = 1024; }
            float lfA[16], lfB[16]; bf16_t qA[16], qB[16], vA[16], vB[16];
            if (it < last) hgrn_pre_load(it, LF, QB, VB, lfA, qA, vA, tid);
            while (it < last) { const int nx = it + step;
                if (nx < last) hgrn_pre_load(nx, LF, QB, VB, lfB, qB, vB, tid);
                hgrn_pre_compute(it, lfA, qA, vA, PRE, DL, (LAS float*)lds, tid);
#pragma unroll
                for (int i = 0; i < 16; ++i) { lfA[i] = lfB[i]; qA[i] = qB[i]; vA[i] = vB[i]; }
                it = nx; }
        }
        __syncthreads();
    }
    SEAM(2);
    if (IN(3)) {
        if (blk < 32) { hgrn_chain(blk >> 3, blk & 7, PRE, DL, ORAW, o_hp, lds, tid); }
        else if (blk < 96) { const int g = blk - 32; s5_scan(g, XLOC, LAMT, UG, o_rp, o_ip, tid);
            pg8::Gemm gm{UG, TB, 640, 640, 640}; pg8::GroupOrder S{g, 1, 2, 1, 0, (size_t)256 * 640, (size_t)512 * 640}; pg8::EpiS2 E{YBUF};
            pg8::gemm_phase<pg8::EpiS2, pg8::GroupOrder, true, true>(lds, gm, S, E); }
        else { const int r = blk - 96, nr = G - 96;
            for (int it = r; it < 1024; it += nr) hgrn_sample_item(it, LF, QB, VB, a.in[2], ORAWS, o_hs, (LAS float*)lds, tid);
            __syncthreads();
            for (int it = r; it < 1024; it += nr) s5_sample_item(it, US, LAMT, BBT, a.in[15], a.in[16], a.in[17], a.in[3], a.in[4], YBUF, o_rs, o_is, (LAS float*)lds, tid); }
        __syncthreads();
    }
    SEAM(3);
    if (IN(4)) {
        { pg8::Gemm g{YBUF, WTGLU, WA, WA, WA}; pg8::TileOrder S; S.init(NTOK, WA, 1, G, blk); pg8::EpiGlu E{YBUF, a.in[20], MIX};
          pg8::gemm_phase<pg8::EpiGlu, pg8::TileOrder, true, true>(lds, g, S, E); }
        __syncthreads();
        if (G > 136) { if (blk >= 136) for (int r = (blk - 136) * 8 + wave; r < NTOK; r += (G - 136) * 8) gate_row(r, ORAW, ORAWS, GB, a.in[10], MIX, lane); }
        else for (int r = gw; r < NTOK; r += NGW) gate_row(r, ORAW, ORAWS, GB, a.in[10], MIX, lane);
        __syncthreads();
    }
    SEAM(4);
    if (IN(5)) {
        pg8::Gemm g{MIX, WTOUT, DM, DM, DM}; pg8::TileOrder S; S.init(NTOK, DM, 1, G, blk); pg8::EpiOut E{x_p, x_s, X1, A2, SS2};
        pg8::gemm_phase<pg8::EpiOut, pg8::TileOrder, true, true>(lds, g, S, E);
        __syncthreads();
        constexpr int I_UP = (DM / 64) * (DFF / 64), I_DN = (DFF / 64) * (DM / 64);
        LAS float* scr = (LAS float*)(lds + wave * TR_WAVE_LDS);
        const int nb2 = G > 16 ? 16 : 0, w0 = (blk - nb2) * 8 + wave, nw = (G - nb2) * 8;
        if (blk >= nb2) for (int it = w0; it < I_UP + I_DN; it += nw) {
            if (it < I_UP) transpose_item(a.in[21], DM, DFF, WTUP, scr, it, lane, a.in[8]);
            else transpose_item(a.in[22], DFF, DM, WTDOWN, scr, it - I_UP, lane, nullptr); }
        __syncthreads();
    }
    SEAM(5);
    if (IN(6)) {
        pg8::Gemm g{A2, WTUP, DM, DM, DM}; pg8::TileOrder S; S.init(NTOK, DFF, 1, G, blk); pg8::EpiUp E{SS2, HH};
        pg8::gemm_phase<pg8::EpiUp, pg8::TileOrder, true, true>(lds, g, S, E);
    }
    SEAM(6);
    if (IN(7)) {
        pg8::Gemm g{HH, WTDOWN, DM, DFF, DFF}; pg8::TileOrder S; S.init(NTOK, DM, 4, G, blk); pg8::EpiDown E{PART};
        pg8::gemm_phase<pg8::EpiDown, pg8::TileOrder, true, true>(lds, g, S, E);
    }
    SEAM(7);
    if (IN(8)) { for (int r = gw; r < NTOK; r += NGW) final_row(r, X1, PART, a.in[23], lane); }
#undef IN
#undef SEAM
}

static int mk_grid = 0;
static void mk_setup() {
    if (mk_grid) return;
    int dev = 0, cus = 0, per_cu = 0;
    (void)hipGetDevice(&dev); (void)hipDeviceGetAttribute(&cus, hipDeviceAttributeMultiprocessorCount, dev);
    (void)hipFuncSetAttribute((const void*)mk, hipFuncAttributeMaxDynamicSharedMemorySize, LDS_BYTES);
    (void)hipOccupancyMaxActiveBlocksPerMultiprocessor(&per_cu, (const void*)mk, 512, LDS_BYTES);
    (void)hipGetLastError();
    mk_grid = cus > 0 ? cus : 256;
    fprintf(stderr, "mk_setup: cus %d per_cu %d grid %d\n", cus, per_cu, mk_grid);
}
static void mk_launch(void* const* d_in, void* d_out, void* d_ws, hipStream_t stream, int lo, int hi, int coop, int omask) {
    mk_setup();
    Args a{};
    for (int i = 0; i < 24; ++i) a.in[i] = (const float*)d_in[i];
    a.out = (float*)d_out; a.ws = (unsigned char*)d_ws; a.ph_lo = lo; a.ph_hi = hi; a.coop = coop; a.omask = omask;
    void* args[] = {&a};
    hipError_t e;
    if (coop) e = hipLaunchCooperativeKernel((const void*)mk, dim3(mk_grid), dim3(512), args, LDS_BYTES, stream);
    else { hipLaunchKernelGGL(mk, dim3(mk_grid), dim3(512), LDS_BYTES, stream, a); e = hipPeekAtLastError(); }
    if (e != hipSuccess) fprintf(stderr, "mk launch failed: %s (grid %d, phases %d..%d)\n", hipGetErrorString(e), mk_grid, lo, hi);
}
extern "C" void kernel_launch(void* const* d_in, const int* in_sizes, int n_in, void* d_out, int out_size, void* d_ws, size_t ws_size, hipStream_t stream) {
    if (ws_size < WS_END || n_in < 24) { fprintf(stderr, "kernel_launch: ws %zu < %zu or n_in %d < 24; nothing launched\n", ws_size, (size_t)WS_END, n_in); return; }
#ifdef PROBE_MASK
    for (int k = 0; k < NPH; ++k) if ((PROBE_MASK >> k) & 1) mk_launch(d_in, d_out, d_ws, stream, k, k + 1, 0, 0);
#endif
    mk_launch(d_in, d_out, d_ws, stream, 0, NPH, 1, 0xFF);
}
```

```cpp
#include <hip/hip_runtime.h>
#include <hip/hip_cooperative_groups.h>
#include <cstdio>
#include <cstdint>
namespace cg = cooperative_groups;

#define LAS __attribute__((address_space(3)))
typedef unsigned short bf16_t;
typedef short bf16x8 __attribute__((ext_vector_type(8)));
typedef float f32x4 __attribute__((ext_vector_type(4)));
typedef float f32x2 __attribute__((ext_vector_type(2)));
typedef unsigned u32x4 __attribute__((ext_vector_type(4)));
typedef unsigned u32x2 __attribute__((ext_vector_type(2)));

typedef __bf16 bf16x2_t __attribute__((ext_vector_type(2)));
__device__ __forceinline__ unsigned cvt_pk_bf16(float lo, float hi) { const f32x2 v = {lo, hi}; return __builtin_bit_cast(unsigned, __builtin_convertvector(v, bf16x2_t)); }
__device__ __forceinline__ float bf_lo(unsigned w) { return __uint_as_float(w << 16); }
__device__ __forceinline__ float bf_hi(unsigned w) { return __uint_as_float(w & 0xffff0000u); }
__device__ __forceinline__ float bf2f(bf16_t v) { return __uint_as_float(((unsigned)v) << 16); }
__device__ __forceinline__ bf16_t f2bf(float f) { return (bf16_t)(cvt_pk_bf16(f, 0.f) & 0xffffu); }
__device__ __forceinline__ float sigm_f(float v) { return __builtin_amdgcn_rcpf(1.f + __expf(-v)); }
__device__ __forceinline__ float silu_f(float v) { return v * __builtin_amdgcn_rcpf(1.f + __expf(-v)); }
__device__ __forceinline__ float gelu_tanh_f(float v) { const float u = 1.5957691216057308f * (v + 0.044715f * v * v * v); return v * __builtin_amdgcn_rcpf(1.f + __expf(-u)); }
__device__ __forceinline__ float wave_sum(float v) {
#pragma unroll
    for (int o = 1; o < 64; o <<= 1) v += __shfl_xor(v, o);
    return v;
}
#define LDS_WAIT() asm volatile("s_waitcnt lgkmcnt(0)" ::: "memory")
#define BAR_LDS() do { asm volatile("s_waitcnt lgkmcnt(0)" ::: "memory"); __builtin_amdgcn_s_barrier(); asm volatile("" ::: "memory"); } while (0)

constexpr int NTOK = 8704, NPROMPT = 8192, DM = 2048, DFF = 8192, INC = 5120, WA = 1024;
constexpr size_t MiB = 1048576;
constexpr size_t WS_UG = 0, WS_XLOC = 20 * MiB, WS_US = 28 * MiB, WS_WTDOWN = 0;
constexpr size_t WS_HB = 32 * MiB, WS_YBUF = 32 * MiB, WS_QB = 66 * MiB, WS_VB = 83 * MiB, WS_GB = 100 * MiB, WS_LF = 117 * MiB, WS_WTGLU = 151 * MiB, WS_WTOUT = 268 * MiB  , WS_H = 32 * MiB;
constexpr size_t WS_WTIN = 168 * MiB, WS_PRE = 168 * MiB, WS_WTUP = 168 * MiB, WS_A2 = 200 * MiB, WS_TB = 234 * MiB, WS_MIX = 234 * MiB, WS_GT = 274 * MiB, WS_PART = 168 * MiB;
constexpr size_t WS_SLOC = 50 * MiB;
constexpr size_t WS_MISC = 304 * MiB, WS_DSEG = WS_MISC + 768 * 1024, WS_CNT = WS_MISC + 832 * 1024  , WS_CNT1 = WS_MISC + 928 * 1024  , WS_CNTP = WS_MISC + 944 * 1024  , WS_CNTS = WS_MISC + 952 * 1024  , WS_BAR = WS_MISC + 960 * 1024  , WS_SS2 = WS_MISC, WS_LB = WS_MISC + 65536, WS_LAMT = WS_MISC + 131072, WS_BBT = WS_MISC + 262144, WS_DL = WS_MISC + MiB, WS_ORAWS = WS_MISC + 2 * MiB, WS_PARTS = 308 * MiB  , WS_END = 316 * MiB;
__device__ __forceinline__ size_t part_off(int z, int row) {
    const size_t base = z == 0 ? 234 * MiB : (z == 1 ? 268 * MiB : (z == 2 ? 168 * MiB : 200 * MiB));
    return row < NPROMPT ? base + (size_t)row * 4096 : WS_PARTS + (size_t)z * 2 * MiB + (size_t)(row - NPROMPT) * 4096;
}
constexpr size_t O_YP = 0, O_HP = 17825792, O_RP = 18350080, O_IP = 18366464, O_HS = 18382848, O_RS = 35160064, O_IS = 35684352;

__device__ __forceinline__ void grid_bar(unsigned* cnt, unsigned target, int tid) {
    __syncthreads();
    if (tid == 0) {
        __builtin_amdgcn_fence(__ATOMIC_RELEASE, "agent");
        asm volatile("s_waitcnt vmcnt(0)" ::: "memory");
        __hip_atomic_fetch_add(cnt, 1u, __ATOMIC_RELAXED, __HIP_MEMORY_SCOPE_AGENT);
        while (__hip_atomic_load(cnt, __ATOMIC_RELAXED, __HIP_MEMORY_SCOPE_AGENT) < target) __builtin_amdgcn_s_sleep(1);
    }
    __syncthreads();
    __builtin_amdgcn_fence(__ATOMIC_ACQUIRE, "agent");
}

__device__ __forceinline__ void wait_lines_acquire(const unsigned* c, int n, unsigned need, int tid) {
    if (tid < n) while (__hip_atomic_load(c + 64 * tid, __ATOMIC_RELAXED, __HIP_MEMORY_SCOPE_AGENT) < need) __builtin_amdgcn_s_sleep(2);
    __syncthreads();
    __builtin_amdgcn_fence(__ATOMIC_ACQUIRE, "agent");
    asm volatile("s_waitcnt vmcnt(0)" ::: "memory");
    __syncthreads();
}
namespace pg8 {
#define PG8_LAS __attribute__((address_space(3)))
constexpr int BM = 256, BK = 64, HALF = 128, HTB = HALF * BK * 2  , STAGE_BYTES = 8 * HTB, NXCD = 8, WGM = 8;
__host__ __device__ __forceinline__ int lds_byte(int r, int c) { const int st = (r >> 4) * 2 + (c >> 5), rr = r & 15, cc = c & 31, ob = rr * 64 + cc * 2; return st * 1024 + (ob ^ (((ob >> 9) & 1) << 5)); }
__host__ __device__ __forceinline__ void stage_rc(int b, int& R, int& C) { const int st = b / 1024, sb = b % 1024, swz = sb ^ (((sb >> 9) & 1) << 5); R = (st >> 1) * 16 + swz / 64; C = (st & 1) * 32 + (swz % 64) / 2; }
__host__ __device__ __forceinline__ int perm32(int rho) { const int n = rho >> 4, i = rho & 15; return 8 * (i >> 2) + 4 * n + (i & 3); }
struct Unit { int pm, pn, z; };
struct Gemm { const bf16_t* A; const bf16_t* Bt; int K, lda, ldb; };

struct TileOrder {
    int nM, nN, nwg, nZ, G, c;
    __device__ __forceinline__ void init(int M, int N, int nZ_, int G_, int c_) { nM = M / BM; nN = N / BM; nwg = nM * nN; nZ = nZ_; G = G_; c = c_; }
    __device__ __forceinline__ bool next(int i, Unit& u) const {
        const long L = (long)i * G + c; if (L >= (long)nwg * nZ) return false;
        u.z = (int)(L / nwg); int wgid = (int)(L % nwg); { const int q = nwg / NXCD, r = nwg % NXCD, xcd = wgid % NXCD, off = wgid / NXCD; wgid = (xcd < r ? xcd * (q + 1) : r * (q + 1) + (xcd - r) * q) + off; }
        const int nig = WGM * nN, gid = wgid / nig, fm = gid * WGM, gsz = (nM - fm) < WGM ? (nM - fm) : WGM;
        u.pm = fm + ((wgid % nig) % gsz); u.pn = (wgid % nig) / gsz; return true;
    }
    __device__ __forceinline__ const char* a_base(const Gemm& g, const Unit& u) const { return (const char*)(g.A + (size_t)u.pm * BM * g.lda + (size_t)u.z * g.K); }
    __device__ __forceinline__ const char* b_base(const Gemm& g, const Unit& u) const { return (const char*)(g.Bt + (size_t)u.pn * BM * g.ldb + (size_t)u.z * g.K); }
    __device__ __forceinline__ void a_ready(const Unit&) const {}
    __device__ __forceinline__ void done(const Unit&) const {}
};
struct GroupOrder {
    int g0, ng, npn, G, c; size_t a_gstride, b_gstride; int pn0;
    __device__ __forceinline__ bool next(int i, Unit& u) const { const int per = i / npn, gi = per * G + c; if (gi >= ng) return false; u.pm = 0; u.pn = pn0 + i % npn; u.z = g0 + gi; return true; }
    __device__ __forceinline__ const char* a_base(const Gemm& g, const Unit& u) const { return (const char*)(g.A + (size_t)u.z * a_gstride); }
    __device__ __forceinline__ const char* b_base(const Gemm& g, const Unit& u) const { return (const char*)(g.Bt + (size_t)u.z * b_gstride + (size_t)u.pn * BM * g.ldb); }
    __device__ __forceinline__ void a_ready(const Unit&) const {}
    __device__ __forceinline__ void done(const Unit&) const {}
};

constexpr int L_C3 = 0, L_C4 = 34, L_CP = 170, L_CG = 204, L_WO = 238, L_WU = 246, L_TOT = 278, L_WD = 279, L_P3ALL = 287, L_P4ALL = 288, L_CALL = 289  , L_CL = 290  , L_GALL = 324  , L_NLINES = 325;
struct FfnOrder {
    int kind, G, c; unsigned* C; unsigned ntot;
    __device__ __forceinline__ bool next(int i, Unit& u) const {
        const int L = i * G + c;
        if (kind == 3) { if (L >= 272) return false; u.z = 0; if (L < 256) { u.pn = L & 7; u.pm = L >> 3; } else { u.pm = 32 + ((L - 256) >> 3); u.pn = L & 7; } return true; }
        if (L >= 1088) return false;
        if (kind == 4) { u.z = 0;
            if (L < 1024) { const int r = L >> 8, j = L & 255, x = j & 7, slot = j >> 3; u.pm = 8 * r + (slot >> 2); u.pn = 4 * x + (slot & 3); }
            else { const int l = L - 1024; u.pm = 32 + (l >> 5); u.pn = l & 31; }
            return true; }
        const int hf = L >= 544 ? 1 : 0, l = L - 544 * hf;
        if (l < 512) { const int r = l >> 7, j = l & 127, x = j & 7, slot = j >> 3; u.z = 2 * hf + (x & 1); u.pn = 4 * ((x >> 1) & 1) + (slot & 3); u.pm = 8 * r + 4 * (x >> 2) + (slot >> 2); }
        else { const int s = l - 512; u.pm = 32 + (s >> 4); u.z = 2 * hf + ((s >> 3) & 1); u.pn = s & 7; }
        return true;
    }
    __device__ __forceinline__ const char* a_base(const Gemm& g, const Unit& u) const { return (const char*)(g.A + (size_t)u.pm * BM * g.lda + (size_t)u.z * g.K); }
    __device__ __forceinline__ const char* b_base(const Gemm& g, const Unit& u) const { return (const char*)(g.Bt + (size_t)u.pn * BM * g.ldb + (size_t)u.z * g.K); }
    static __device__ __forceinline__ void spin(const unsigned* w, unsigned need) { while ((unsigned)__builtin_amdgcn_readfirstlane(__hip_atomic_load(w, __ATOMIC_RELAXED, __HIP_MEMORY_SCOPE_AGENT)) < need) __builtin_amdgcn_s_sleep(2); }
    __device__ __forceinline__ void a_ready(const Unit& u) const {
        if (threadIdx.x < 64) {
            if (kind == 3) { spin(C + 64 * (L_CG + u.pm), 256u); spin(C + 64 * (L_CL + u.pm), 32u); spin(C + 64 * (L_WO + u.pn), 128u); }
            else if (kind == 4) { spin(C + 64 * (L_C3 + u.pm), 64u); spin(C + 64 * (L_WU + u.pn), 128u); spin(C + 64 * L_TOT, ntot); spin(C + 64 * L_GALL, 1088u); }
            else { spin(C + 64 * (L_C4 + u.pm * 4 + u.z), 64u); spin(C + 64 * (L_WD + u.pn), 512u);
                if (u.z == 1) spin(C + 64 * L_P3ALL, 2176u);
                if (u.z >= 2) spin(C + 64 * L_P4ALL, 8704u); }
            __builtin_amdgcn_fence(__ATOMIC_ACQUIRE, "agent");
            asm volatile("s_waitcnt vmcnt(0)" ::: "memory");
        }
        asm volatile("" ::: "memory"); __builtin_amdgcn_s_barrier(); asm volatile("" ::: "memory");
    }
    __device__ __forceinline__ void done(const Unit& u) const {
        asm volatile("s_waitcnt vmcnt(0)" ::: "memory");
        if ((threadIdx.x & 63) == 0) {
            if (kind == 3) { __hip_atomic_fetch_add(C + 64 * (L_C3 + u.pm), 1u, __ATOMIC_RELAXED, __HIP_MEMORY_SCOPE_AGENT); __hip_atomic_fetch_add(C + 64 * L_P3ALL, 1u, __ATOMIC_RELAXED, __HIP_MEMORY_SCOPE_AGENT); }
            else if (kind == 4) { __hip_atomic_fetch_add(C + 64 * (L_C4 + u.pm * 4 + (u.pn >> 3)), 1u, __ATOMIC_RELAXED, __HIP_MEMORY_SCOPE_AGENT); __hip_atomic_fetch_add(C + 64 * L_P4ALL, 1u, __ATOMIC_RELAXED, __HIP_MEMORY_SCOPE_AGENT); }
            else __hip_atomic_fetch_add(C + 64 * (L_CP + u.pm), 1u, __ATOMIC_RELAXED, __HIP_MEMORY_SCOPE_AGENT);
        }
    }
};

struct TileOrderPub : TileOrder {
    unsigned* cnt;
    __device__ __forceinline__ void done(const Unit& u) const {
        asm volatile("s_waitcnt vmcnt(0)" ::: "memory");
        if ((threadIdx.x & 63) == 0) { __hip_atomic_fetch_add(cnt + 64 * u.pm, 1u, __ATOMIC_RELAXED, __HIP_MEMORY_SCOPE_AGENT); __hip_atomic_fetch_add(cnt + 64 * 34, 1u, __ATOMIC_RELAXED, __HIP_MEMORY_SCOPE_AGENT); }
    }
};
struct TileOrderDep : TileOrder {
    const unsigned* cntH; const unsigned* cntW;
    __device__ __forceinline__ void a_ready(const Unit& u) const {
        if (threadIdx.x < 64) {
            while ((unsigned)__builtin_amdgcn_readfirstlane(__hip_atomic_load(cntH + 64 * u.pm, __ATOMIC_RELAXED, __HIP_MEMORY_SCOPE_AGENT)) < 256u) __builtin_amdgcn_s_sleep(2);
            while ((unsigned)__builtin_amdgcn_readfirstlane(__hip_atomic_load(cntW + 64 * u.pn, __ATOMIC_RELAXED, __HIP_MEMORY_SCOPE_AGENT)) < 128u) __builtin_amdgcn_s_sleep(2);
            __builtin_amdgcn_fence(__ATOMIC_ACQUIRE, "agent");
            asm volatile("s_waitcnt vmcnt(0)" ::: "memory");
        }
        asm volatile("" ::: "memory"); __builtin_amdgcn_s_barrier(); asm volatile("" ::: "memory");
    }
};
template <class Epi, class Sched, bool ALIGN_EPI = false, bool SP2 = false, int AUXA = 0  >
__device__ __forceinline__ void gemm_phase(PG8_LAS unsigned char* lds, const Gemm g, const Sched& S, const Epi& E) {
    const int tid = threadIdx.x, wid = __builtin_amdgcn_readfirstlane(tid >> 6), lane = tid & 63, wr = wid >> 2, wc = wid & 3, fr = lane & 15, fq = lane >> 4;
    const int K = g.K, nt = K / BK, lda = g.lda, ldb = g.ldb;
    unsigned voffA[2], voffB[2];
#pragma unroll
    for (int i = 0; i < 2; ++i) { int R, C; stage_rc(tid * 16 + i * 8192, R, C); const int Rb = Epi::PERM ? ((R & ~31) + perm32(R & 31)) : R;
        voffA[i] = (unsigned)(R * lda + C) * 2u; voffB[i] = (unsigned)(Rb * ldb + C) * 2u; }
    const size_t kstep = (size_t)(BK * 2);
    const size_t hstepA = (size_t)HALF * lda * 2, hstepB = (size_t)HALF * ldb * 2;
    const unsigned ldsw = (unsigned)wid * 1024u;
    const int aoff = lds_byte(wr * 64 + fr, fq * 8), boff = lds_byte(wc * 32 + fr, fq * 8);
#define PG8_SA(b, h) (((b) * 2 + (h)) * HTB)
#define PG8_SB(b, h) ((4 + (b) * 2 + (h)) * HTB)
#define PG8_STAGE_X(bufoff, gbase, voff, AUX) do { _Pragma("unroll") for (int _i = 0; _i < 2; ++_i) \
        __builtin_amdgcn_global_load_lds((const unsigned*)((const char*)(gbase) + (voff)[_i]), (PG8_LAS unsigned*)(lds + (bufoff) + ldsw + _i * 8192), 16, 0, AUX); } while (0)
#define PG8_STAGE(bufoff, gbase, voff) PG8_STAGE_X(bufoff, gbase, voff, 0)
#define PG8_STAGEA(bufoff, gbase, voff) PG8_STAGE_X(bufoff, gbase, voff, AUXA)
#define PG8_LDA(dst, b, h) do { _Pragma("unroll") for (int m = 0; m < 4; ++m) _Pragma("unroll") for (int k = 0; k < 2; ++k) dst[m][k] = *(const PG8_LAS bf16x8*)(lds + PG8_SA(b, h) + aoff + m * 2048 + k * 1024); } while (0)
#define PG8_LDB(dst, b, h) do { _Pragma("unroll") for (int n = 0; n < 2; ++n) _Pragma("unroll") for (int k = 0; k < 2; ++k) dst[n][k] = *(const PG8_LAS bf16x8*)(lds + PG8_SB(b, h) + boff + n * 2048 + k * 1024); } while (0)
#define PG8_MMA(ai, bj, At, Bt) do { __builtin_amdgcn_s_setprio(1); _Pragma("unroll") for (int m = 0; m < 4; ++m) _Pragma("unroll") for (int n = 0; n < 2; ++n) _Pragma("unroll") for (int k = 0; k < 2; ++k) \
        acc[ai][bj][m][n] = __builtin_amdgcn_mfma_f32_16x16x32_bf16(Bt[n][k], At[m][k], acc[ai][bj][m][n], 0, 0, 0); __builtin_amdgcn_s_setprio(0); } while (0)
#define PG8_WAIT_V(n) asm volatile("s_waitcnt vmcnt(" #n ")" ::: "memory")
#define PG8_WAIT_L(n) asm volatile("s_waitcnt lgkmcnt(" #n ")" ::: "memory")
#define PG8_BAR __builtin_amdgcn_s_barrier()
#define PG8_SCHED __builtin_amdgcn_sched_barrier(0)
    Unit cur, nxt; int ui = 0;
    if (!S.next(0, cur)) return;
    f32x4 acc[2][2][4][2];
#pragma unroll
    for (int a = 0; a < 2; ++a)
#pragma unroll
        for (int b = 0; b < 2; ++b)
#pragma unroll
            for (int m = 0; m < 4; ++m)
#pragma unroll
                for (int n = 0; n < 2; ++n) acc[a][b][m][n] = (f32x4){0.f, 0.f, 0.f, 0.f};
    bf16x8 At[4][2], B0[2][2], B1[2][2];
    const char* cA = S.a_base(g, cur); const char* cB = S.b_base(g, cur);
    S.a_ready(cur);
    if constexpr (SP2) {
        PG8_STAGE(PG8_SB(0, 0), cB, voffB); PG8_STAGE(PG8_SB(0, 1), cB + hstepB, voffB); PG8_STAGEA(PG8_SA(0, 0), cA, voffA); PG8_STAGEA(PG8_SA(0, 1), cA + hstepA, voffA);
        if (wr == 1) PG8_BAR;
        PG8_WAIT_V(2); PG8_BAR;
        PG8_STAGE(PG8_SB(1, 0), cB + kstep, voffB); PG8_STAGEA(PG8_SA(1, 0), cA + kstep, voffA); PG8_STAGE(PG8_SB(1, 1), cB + hstepB + kstep, voffB);
        PG8_WAIT_V(6); PG8_BAR;
    } else {
        PG8_STAGE(PG8_SB(0, 0), cB, voffB); PG8_STAGEA(PG8_SA(0, 0), cA, voffA); PG8_STAGE(PG8_SB(0, 1), cB + hstepB, voffB); PG8_STAGEA(PG8_SA(0, 1), cA + hstepA, voffA);
        if (wr == 1) PG8_BAR;
        PG8_WAIT_V(4); PG8_BAR;
        PG8_STAGE(PG8_SB(1, 0), cB + kstep, voffB); PG8_STAGEA(PG8_SA(1, 0), cA + kstep, voffA); PG8_STAGE(PG8_SB(1, 1), cB + hstepB + kstep, voffB);
        PG8_WAIT_V(6); PG8_BAR;
    }
    for (;;) {
        const bool has_next = S.next(ui + 1, nxt);
        const char* nA = has_next ? S.a_base(g, nxt) : cA; const char* nB = has_next ? S.b_base(g, nxt) : cB;
        for (int t = 0; t < nt; t += 2) {
            const bool last = (t == nt - 2);
            const char* a1 = cA + (size_t)(t + 1) * kstep;
            const char* a2 = last ? nA : cA + (size_t)(t + 2) * kstep; const char* b2 = last ? nB : cB + (size_t)(t + 2) * kstep;
            const char* a3 = a2 + kstep; const char* b3 = b2 + kstep;
            if (last && has_next) S.a_ready(nxt);
            if constexpr (SP2) {
            PG8_LDB(B0, 0, 0); PG8_LDB(B1, 0, 1); PG8_SCHED; PG8_LDA(At, 0, 0); PG8_STAGEA(PG8_SA(1, 1), a1 + hstepA, voffA);
            PG8_WAIT_V(8); PG8_WAIT_L(0); PG8_BAR; PG8_MMA(0, 0, At, B0); PG8_MMA(0, 1, At, B1); PG8_BAR; PG8_SCHED;
            PG8_LDA(At, 0, 1); PG8_STAGE(PG8_SB(0, 0), b2, voffB); PG8_STAGE(PG8_SB(0, 1), b2 + hstepB, voffB); PG8_STAGEA(PG8_SA(0, 0), a2, voffA);
            PG8_WAIT_V(8); PG8_WAIT_L(0); PG8_BAR; PG8_MMA(1, 0, At, B0); PG8_MMA(1, 1, At, B1); PG8_BAR; PG8_SCHED;
            PG8_LDB(B0, 1, 0); PG8_LDB(B1, 1, 1); PG8_SCHED; PG8_LDA(At, 1, 0); PG8_STAGEA(PG8_SA(0, 1), a2 + hstepA, voffA);
            PG8_WAIT_V(8); PG8_WAIT_L(0); PG8_BAR; PG8_MMA(0, 0, At, B0); PG8_MMA(0, 1, At, B1); PG8_BAR; PG8_SCHED;
            PG8_LDA(At, 1, 1); PG8_STAGE(PG8_SB(1, 0), b3, voffB); PG8_STAGE(PG8_SB(1, 1), b3 + hstepB, voffB); PG8_STAGEA(PG8_SA(1, 0), a3, voffA);
            PG8_WAIT_V(8); PG8_WAIT_L(0); PG8_BAR; PG8_MMA(1, 0, At, B0); PG8_MMA(1, 1, At, B1); PG8_BAR; PG8_SCHED;
            } else {
            PG8_LDB(B0, 0, 0); PG8_SCHED; PG8_LDA(At, 0, 0); PG8_STAGEA(PG8_SA(1, 1), a1 + hstepA, voffA);
            PG8_WAIT_L(8); PG8_BAR; PG8_WAIT_L(0); PG8_MMA(0, 0, At, B0); PG8_BAR; PG8_SCHED;
            PG8_LDB(B1, 0, 1); PG8_STAGE(PG8_SB(0, 0), b2, voffB);
            PG8_BAR; PG8_WAIT_L(0); PG8_MMA(0, 1, At, B1); PG8_BAR;
            PG8_LDA(At, 0, 1); PG8_STAGEA(PG8_SA(0, 0), a2, voffA);
            PG8_BAR; PG8_WAIT_L(0); PG8_MMA(1, 0, At, B0); PG8_BAR; PG8_SCHED;
            PG8_STAGE(PG8_SB(0, 1), b2 + hstepB, voffB);
            PG8_WAIT_V(6); PG8_BAR; PG8_MMA(1, 1, At, B1); PG8_BAR;
            PG8_LDB(B0, 1, 0); PG8_SCHED; PG8_LDA(At, 1, 0); PG8_STAGEA(PG8_SA(0, 1), a2 + hstepA, voffA);
            PG8_WAIT_L(8); PG8_BAR; PG8_WAIT_L(0); PG8_MMA(0, 0, At, B0); PG8_BAR; PG8_SCHED;
            PG8_LDB(B1, 1, 1); PG8_STAGE(PG8_SB(1, 0), b3, voffB);
            PG8_BAR; PG8_WAIT_L(0); PG8_MMA(0, 1, At, B1); PG8_BAR;
            PG8_LDA(At, 1, 1); PG8_STAGEA(PG8_SA(1, 0), a3, voffA);
            PG8_BAR; PG8_WAIT_L(0); PG8_MMA(1, 0, At, B0); PG8_BAR; PG8_SCHED;
            PG8_STAGE(PG8_SB(1, 1), b3 + hstepB, voffB);
            PG8_WAIT_V(6); PG8_BAR; PG8_MMA(1, 1, At, B1); PG8_BAR;
            }
        }
        if constexpr (ALIGN_EPI) { if (wr == 0) PG8_BAR; }
        if constexpr (!Epi::AFTER_DRAIN) { E(acc, cur, wr, wc, fr, fq); S.done(cur); }
        if (!has_next) break;
#pragma unroll
        for (int a = 0; a < 2; ++a)
#pragma unroll
            for (int b = 0; b < 2; ++b)
#pragma unroll
                for (int m = 0; m < 4; ++m)
#pragma unroll
                    for (int n = 0; n < 2; ++n) acc[a][b][m][n] = (f32x4){0.f, 0.f, 0.f, 0.f};
        cur = nxt; cA = nA; cB = nB; ++ui;
        if constexpr (ALIGN_EPI) { if (wr == 1) PG8_BAR; }
    }
    PG8_WAIT_V(0);
    if constexpr (!ALIGN_EPI) { if (wr == 0) PG8_BAR; }
    PG8_BAR;
    if constexpr (Epi::AFTER_DRAIN) { E.fused(acc, cur, wr, wc, fr, fq, lds, wid, lane); S.done(cur); }
#undef PG8_SA
#undef PG8_SB
#undef PG8_STAGE
#undef PG8_STAGEA
#undef PG8_STAGE_X
#undef PG8_LDA
#undef PG8_LDB
#undef PG8_MMA
#undef PG8_WAIT_V
#undef PG8_WAIT_L
#undef PG8_BAR
#undef PG8_SCHED
}
}
namespace pg8 {
#define EPI_FOR_ROWS _Pragma("unroll") for (int ai = 0; ai < 2; ++ai) _Pragma("unroll") for (int m = 0; m < 4; ++m)
#define EPI_ROW (u.pm * BM + ai * HALF + wr * 64 + m * 16 + fr)
#define EPI_PK8(v0, v1) ((u32x4){cvt_pk_bf16((v0)[0], (v0)[1]), cvt_pk_bf16((v0)[2], (v0)[3]), cvt_pk_bf16((v1)[0], (v1)[1]), cvt_pk_bf16((v1)[2], (v1)[3])})

struct Epi1 {
    static constexpr bool PERM = true, AFTER_DRAIN = false;
    unsigned char* ws; const float* LB;
    __device__ __forceinline__ void operator()(const f32x4 (&acc)[2][2][4][2], const Unit& u, int wr, int wc, int fr, int fq) const {
        const int kind = u.pn >> 2, colt = (u.pn & 3) * BM + wc * 32 + 8 * fq;
        if (kind == 1) {
            f32x4 lb0[2], lb1[2];
#pragma unroll
            for (int bj = 0; bj < 2; ++bj) {
                const f32x4 a0 = *(const f32x4*)(LB + colt + bj * HALF), a1 = *(const f32x4*)(LB + colt + bj * HALF + 4), c0 = *(const f32x4*)(LB + WA + colt + bj * HALF), c1 = *(const f32x4*)(LB + WA + colt + bj * HALF + 4);
#pragma unroll
                for (int j = 0; j < 4; ++j) { const float e0 = __expf(a0[j]), f0 = __expf(c0[j]), e1 = __expf(a1[j]), f1 = __expf(c1[j]); lb0[bj][j] = e0 / (e0 + f0); lb1[bj][j] = e1 / (e1 + f1); } }
            EPI_FOR_ROWS { const int row = EPI_ROW;
#pragma unroll
                for (int bj = 0; bj < 2; ++bj) { f32x4 v0 = acc[ai][bj][m][0], v1 = acc[ai][bj][m][1];
#pragma unroll
                    for (int j = 0; j < 4; ++j) { v0[j] = __logf(lb0[bj][j] + (1.f - lb0[bj][j]) * sigm_f(v0[j])); v1[j] = __logf(lb1[bj][j] + (1.f - lb1[bj][j]) * sigm_f(v1[j])); }
                    float* p = (float*)(ws + WS_LF) + (size_t)row * WA + colt + bj * HALF; __builtin_nontemporal_store(v0, (f32x4*)p); __builtin_nontemporal_store(v1, (f32x4*)(p + 4)); } }
        } else if (kind == 4) {
            EPI_FOR_ROWS { const int row = EPI_ROW;
#pragma unroll
                for (int bj = 0; bj < 2; ++bj) { const int col = colt + bj * HALF; const u32x4 w = EPI_PK8(acc[ai][bj][m][0], acc[ai][bj][m][1]);
                    if (row < NPROMPT) __builtin_nontemporal_store(w, (u32x4*)((bf16_t*)(ws + WS_UG) + ((size_t)((col >> 4) * 256 + (row >> 5)) * 640 + (row & 31) * 16 + (col & 15))));
                    else __builtin_nontemporal_store(w, (u32x4*)((bf16_t*)(ws + WS_US) + (size_t)(row - NPROMPT) * WA + col)); } }
        } else {
            const size_t ooff = kind == 0 ? WS_QB : (kind == 2 ? WS_VB : WS_GB); bf16_t* O = (bf16_t*)(ws + ooff);
            EPI_FOR_ROWS { const int row = EPI_ROW;
#pragma unroll
                for (int bj = 0; bj < 2; ++bj) { f32x4 v0 = acc[ai][bj][m][0], v1 = acc[ai][bj][m][1];
                    if (kind != 2) {
#pragma unroll
                        for (int j = 0; j < 4; ++j) { v0[j] = silu_f(v0[j]); v1[j] = silu_f(v1[j]); } }
                    __builtin_nontemporal_store(EPI_PK8(v0, v1), (u32x4*)(O + (size_t)row * WA + colt + bj * HALF)); } }
        }
    }
};
struct EpiS1 {
    static constexpr bool PERM = false, AFTER_DRAIN = false;
    float* XLOC;
    __device__ __forceinline__ void operator()(const f32x4 (&acc)[2][2][4][2], const Unit& u, int wr, int wc, int fr, int fq) const {
        EPI_FOR_ROWS { const int row = EPI_ROW;
#pragma unroll
            for (int n = 0; n < 2; ++n) *(f32x4*)(XLOC + ((size_t)u.z * 256 + row) * 128 + wc * 32 + n * 16 + 4 * fq) = acc[ai][0][m][n]; }
    }
};
struct EpiS2 {
    static constexpr bool PERM = true, AFTER_DRAIN = false;
    bf16_t* YBUF;
    __device__ __forceinline__ void operator()(const f32x4 (&acc)[2][2][4][2], const Unit& u, int wr, int wc, int fr, int fq) const {
        EPI_FOR_ROWS { const int row = EPI_ROW;
#pragma unroll
            for (int bj = 0; bj < 2; ++bj) { const int n8 = u.pn * BM + bj * HALF + wc * 32 + 8 * fq; f32x4 v0 = acc[ai][bj][m][0], v1 = acc[ai][bj][m][1];
#pragma unroll
                for (int j = 0; j < 4; ++j) { v0[j] = gelu_tanh_f(v0[j]); v1[j] = gelu_tanh_f(v1[j]); }
                *(u32x4*)(YBUF + ((size_t)row * 32 + (n8 >> 4)) * WA + u.z * 16 + (n8 & 15)) = EPI_PK8(v0, v1); } }
    }
};
struct EpiGlu {
    static constexpr bool PERM = true, AFTER_DRAIN = false;
    const bf16_t* YBUF; const float* gb; bf16_t* MIX;
    __device__ __forceinline__ void operator()(const f32x4 (&acc)[2][2][4][2], const Unit& u, int wr, int wc, int fr, int fq) const {
        const int colt = u.pn * BM + wc * 32 + 8 * fq;
        const __amdgpu_buffer_rsrc_t mr = __builtin_amdgcn_make_buffer_rsrc(MIX, 0, NTOK * DM * 2, 0x00020000);
        f32x4 b0[2], b1[2];
#pragma unroll
        for (int bj = 0; bj < 2; ++bj) { b0[bj] = *(const f32x4*)(gb + colt + bj * HALF); b1[bj] = *(const f32x4*)(gb + colt + bj * HALF + 4); }
        EPI_FOR_ROWS { const int row = EPI_ROW;
#pragma unroll
            for (int bj = 0; bj < 2; ++bj) { const int col = colt + bj * HALF; const u32x4 yw = *(const u32x4*)(YBUF + (size_t)row * WA + col);
                const f32x4 z0 = acc[ai][bj][m][0] + b0[bj], z1 = acc[ai][bj][m][1] + b1[bj]; f32x4 v0, v1;
                v0[0] = bf_lo(yw[0]) * sigm_f(z0[0]); v0[1] = bf_hi(yw[0]) * sigm_f(z0[1]); v0[2] = bf_lo(yw[1]) * sigm_f(z0[2]); v0[3] = bf_hi(yw[1]) * sigm_f(z0[3]);
                v1[0] = bf_lo(yw[2]) * sigm_f(z1[0]); v1[1] = bf_hi(yw[2]) * sigm_f(z1[1]); v1[2] = bf_lo(yw[3]) * sigm_f(z1[2]); v1[3] = bf_hi(yw[3]) * sigm_f(z1[3]);
                __builtin_amdgcn_raw_buffer_store_b128(EPI_PK8(v0, v1), mr, (unsigned)(((size_t)row * DM + WA + col) * 2), 0, 16); } }
    }
};
struct EpiOut {
    static constexpr bool PERM = true, AFTER_DRAIN = false;
    const float *xp, *xs; float* X1; bf16_t* A2; float* SS2;
    __device__ __forceinline__ void operator()(const f32x4 (&acc)[2][2][4][2], const Unit& u, int wr, int wc, int fr, int fq) const {
        const int colt = u.pn * BM + wc * 32 + 8 * fq;
        const __amdgpu_buffer_rsrc_t rs = __builtin_amdgcn_make_buffer_rsrc(A2, 0, NTOK * DM * 2, 0x00020000), xr1 = __builtin_amdgcn_make_buffer_rsrc(X1, 0, NTOK * DM * 4, 0x00020000);
        EPI_FOR_ROWS { const int row = EPI_ROW;
            const float* xr = row < NPROMPT ? xp + (size_t)row * DM : xs + (size_t)(row - NPROMPT) * DM; float ss = 0.f;
#pragma unroll
            for (int bj = 0; bj < 2; ++bj) { const int col = colt + bj * HALF; const f32x4 v0 = acc[ai][bj][m][0] + __builtin_nontemporal_load((const f32x4*)(xr + col)), v1 = acc[ai][bj][m][1] + __builtin_nontemporal_load((const f32x4*)(xr + col + 4));
                __builtin_amdgcn_raw_buffer_store_b128(__builtin_bit_cast(u32x4, v0), xr1, (unsigned)(((size_t)row * DM + col) * 4), 0, 16); __builtin_amdgcn_raw_buffer_store_b128(__builtin_bit_cast(u32x4, v1), xr1, (unsigned)(((size_t)row * DM + col + 4) * 4), 0, 16);
                __builtin_amdgcn_raw_buffer_store_b128(EPI_PK8(v0, v1), rs, (unsigned)(((size_t)row * DM + col) * 2), 0, 16);
                ss += (v0[0] * v0[0] + v0[1] * v0[1]) + (v0[2] * v0[2] + v0[3] * v0[3]) + (v1[0] * v1[0] + v1[1] * v1[1]) + (v1[2] * v1[2] + v1[3] * v1[3]); }
            ss += __shfl_xor(ss, 16); ss += __shfl_xor(ss, 32);
            if (fq == 0) __hip_atomic_fetch_add(SS2 + row, ss, __ATOMIC_RELAXED, __HIP_MEMORY_SCOPE_AGENT); }
    }
};
struct EpiUp {
    static constexpr bool PERM = true, AFTER_DRAIN = false;
    const float* SS2; bf16_t* H;
    __device__ __forceinline__ void operator()(const f32x4 (&acc)[2][2][4][2], const Unit& u, int wr, int wc, int fr, int fq) const {
        const int colt = u.pn * BM + wc * 32 + 8 * fq;
        const __amdgpu_buffer_rsrc_t hr = __builtin_amdgcn_make_buffer_rsrc(H, 0, (unsigned)((size_t)NTOK * DFF * 2), 0x00020000);
        EPI_FOR_ROWS { const int row = EPI_ROW;
            const float rs = rsqrtf(SS2[row] * (1.f / DM) + 1e-6f);
#pragma unroll
            for (int bj = 0; bj < 2; ++bj) { f32x4 v0 = acc[ai][bj][m][0] * rs, v1 = acc[ai][bj][m][1] * rs;
#pragma unroll
                for (int j = 0; j < 4; ++j) { const float a = fmaxf(v0[j], 0.f), b = fmaxf(v1[j], 0.f); v0[j] = a * a; v1[j] = b * b; }
                __builtin_amdgcn_raw_buffer_store_b128(EPI_PK8(v0, v1), hr, (unsigned)(((size_t)row * DFF + colt + bj * HALF) * 2), 0, 16); } }
    }
};
struct EpiDown {
    static constexpr bool PERM = true, AFTER_DRAIN = false;
    unsigned char* ws;
    __device__ __forceinline__ void operator()(const f32x4 (&acc)[2][2][4][2], const Unit& u, int wr, int wc, int fr, int fq) const {
        const int colt = u.pn * BM + wc * 32 + 8 * fq;
        const __amdgpu_buffer_rsrc_t pr = __builtin_amdgcn_make_buffer_rsrc(ws, 0, (unsigned)WS_END, 0x00020000);
        EPI_FOR_ROWS { const int row = EPI_ROW; const unsigned ro = (unsigned)part_off(u.z, row);
#pragma unroll
            for (int bj = 0; bj < 2; ++bj) __builtin_amdgcn_raw_buffer_store_b128(EPI_PK8(acc[ai][bj][m][0], acc[ai][bj][m][1]), pr, ro + (unsigned)((colt + bj * HALF) * 2), 0, 16); }
    }
};
}
constexpr int TR_WAVE_LDS = 64 * 65 * 4;
template <bool WT_SC1 = false, bool NMAJOR = false>
__device__ __forceinline__ void transpose_item(const float* W, int K, int N, bf16_t* WT, LAS float* scr, int item, int lane, const float* kscale) {
    const int nblk = N / 64, kblk = K / 64, kb = NMAJOR ? item % kblk : item / nblk, nb = NMAJOR ? item / kblk : item % nblk, k0 = 64 * kb, n0 = 64 * nb, kr = lane >> 4, n4 = (lane & 15) * 4;
    f32x4 v[16];
#pragma unroll
    for (int i = 0; i < 16; ++i) v[i] = __builtin_nontemporal_load((const f32x4*)(W + (size_t)(k0 + 4 * i + kr) * N + n0 + n4));
#pragma unroll
    for (int i = 0; i < 16; ++i) { const int k = 4 * i + kr; f32x4 x = v[i]; if (kscale) x = x * kscale[k0 + k]; LAS float* d = scr + k * 65 + n4; d[0] = x[0]; d[1] = x[1]; d[2] = x[2]; d[3] = x[3]; }
    LDS_WAIT();
    const int c = lane & 7;
#pragma unroll
    for (int j = 0; j < 8; ++j) { const int n = (lane >> 3) + 8 * j; const LAS float* s = scr + (8 * c) * 65 + n;
        u32x4 o; o.x = cvt_pk_bf16(s[0 * 65], s[1 * 65]); o.y = cvt_pk_bf16(s[2 * 65], s[3 * 65]); o.z = cvt_pk_bf16(s[4 * 65], s[5 * 65]); o.w = cvt_pk_bf16(s[6 * 65], s[7 * 65]);
        if (WT_SC1) { const __amdgpu_buffer_rsrc_t wr = __builtin_amdgcn_make_buffer_rsrc(WT, 0, (unsigned)((size_t)N * K * 2), 0x00020000); __builtin_amdgcn_raw_buffer_store_b128(o, wr, (unsigned)(((size_t)(n0 + n) * K + k0 + 8 * c) * 2), 0, 16); }
        else *(u32x4*)(WT + (size_t)(n0 + n) * K + k0 + 8 * c) = o; }
    LDS_WAIT();
}
__device__ __forceinline__ void rms_row_bf16(const float* xrow, const float* g, bf16_t* orow, int lane) {
    const f32x4* xr = (const f32x4*)xrow + lane; f32x4 v[8]; float s = 0.f;
#pragma unroll
    for (int j = 0; j < 8; ++j) { v[j] = __builtin_nontemporal_load(xr + 64 * j); s += (v[j][0] * v[j][0] + v[j][1] * v[j][1]) + (v[j][2] * v[j][2] + v[j][3] * v[j][3]); }
    const float rstd = rsqrtf(wave_sum(s) * (1.f / DM) + 1e-6f);
    const f32x4* gr = (const f32x4*)g + lane; u32x2* o8 = (u32x2*)orow + lane;
#pragma unroll
    for (int j = 0; j < 8; ++j) { const f32x4 gv = gr[64 * j]; const unsigned long long w = (unsigned long long)cvt_pk_bf16(v[j][0] * rstd * gv[0], v[j][1] * rstd * gv[1]) | ((unsigned long long)cvt_pk_bf16(v[j][2] * rstd * gv[2], v[j][3] * rstd * gv[3]) << 32);
        __hip_atomic_store((unsigned long long*)(o8 + 64 * j), w, __ATOMIC_RELAXED, __HIP_MEMORY_SCOPE_AGENT); }
}

__device__ __forceinline__ void s5_table_item(int g, int q, const float* a_re, const float* a_im, const float* b_re, const float* b_im, const float* c_re, const float* c_im, const float* dd, const float* log_step,
                                              bf16_t* TB, bf16_t* GT, float* LAMT, float* BBT, LAS float* L, int tid) {
    LAS float* LAMR = L; LAS float* LAMI = L + 2112; LAS float* BBR = L + 4224; LAS float* BBI = L + 5248; LAS float* CR = L + 6272; LAS float* CI = L + 7296; LAS float* KQ = L + 8320;
    const float dt = __expf(log_step[g]);
    for (int idx = tid; idx < 2112; idx += 512) { const int j = idx >> 6, p = idx & 63; const float are = a_re[g * 64 + p], aim = a_im[g * 64 + p];
        const float mag = __expf((float)j * are * dt); const float rev = (float)j * (aim * dt) * 0.15915494309189535f; const float fr = rev - rintf(rev);
        LAMR[idx] = mag * cosf(fr * 6.283185307179586f); LAMI[idx] = mag * sinf(fr * 6.283185307179586f); }
    for (int idx = tid; idx < 1024; idx += 512) { const int p = idx >> 4; const float are = a_re[g * 64 + p], aim = a_im[g * 64 + p];
        const float mag = __expf(are * dt); const float rev = (aim * dt) * 0.15915494309189535f; const float fr = rev - rintf(rev);
        const float lr = mag * cosf(fr * 6.283185307179586f), li = mag * sinf(fr * 6.283185307179586f);
        const float den = are * are + aim * aim, nr = lr - 1.f, ni = li, rr = (nr * are + ni * aim) / den, ri = (ni * are - nr * aim) / den;
        const float br = b_re[g * 1024 + idx], bi = b_im[g * 1024 + idx]; BBR[idx] = rr * br - ri * bi; BBI[idx] = rr * bi + ri * br;
        CR[idx] = c_re[g * 1024 + idx]; CI[idx] = c_im[g * 1024 + idx]; }
    __syncthreads();
    {
        const int cc = tid & 255, jh = tid >> 8, c = cc >> 4, c1 = cc & 15; float a4[4] = {0.f, 0.f, 0.f, 0.f};
        for (int p = 0; p < 64; ++p) { const float cr = CR[c * 64 + p], ci = CI[c * 64 + p], br = BBR[p * 16 + c1], bi = BBI[p * 16 + c1]; const float cbr = cr * br - ci * bi, cbi = cr * bi + ci * br;
#pragma unroll
            for (int e = 0; e < 4; ++e) { const int j = 8 * q + 4 * jh + e; a4[e] += LAMR[j * 64 + p] * cbr - LAMI[j * 64 + p] * cbi; } }
#pragma unroll
        for (int e = 0; e < 4; ++e) { const int j = 8 * q + 4 * jh + e; KQ[(4 * jh + e) * 256 + cc] = a4[e] + ((j == 0 && c == c1) ? dd[g * 16 + c] : 0.f); }
    }
    __syncthreads();
    bf16_t* TBg = TB + (size_t)g * 512 * 640;
    for (int idx = tid; idx < 4096; idx += 512) {
        const int jl = idx >> 9, t = (idx >> 4) & 31, c = idx & 15, j = 8 * q + jl;
        if (t >= j) { const LAS float* k = KQ + jl * 256 + c * 16; u32x4 w0, w1;
            w0.x = cvt_pk_bf16(k[0], k[1]); w0.y = cvt_pk_bf16(k[2], k[3]); w0.z = cvt_pk_bf16(k[4], k[5]); w0.w = cvt_pk_bf16(k[6], k[7]);
            w1.x = cvt_pk_bf16(k[8], k[9]); w1.y = cvt_pk_bf16(k[10], k[11]); w1.z = cvt_pk_bf16(k[12], k[13]); w1.w = cvt_pk_bf16(k[14], k[15]);
            u32x4* d = (u32x4*)(TBg + (size_t)(t * 16 + c) * 640 + (t - j) * 16); d[0] = w0; d[1] = w1; } }
    for (int idx = tid; idx < 4096; idx += 512) {
        const int tl = idx >> 9, c = (idx >> 5) & 15, s = idx & 31, t = 8 * q + tl;
        if (s > t) { u32x4* d = (u32x4*)(TBg + (size_t)(t * 16 + c) * 640 + s * 16); d[0] = (u32x4){0u, 0u, 0u, 0u}; d[1] = (u32x4){0u, 0u, 0u, 0u}; } }
    for (int idx = tid; idx < 16384; idx += 512) {
        const int p = idx & 63, ri = (idx >> 6) & 1, c = (idx >> 7) & 15, tl = idx >> 11, t = 8 * q + tl;
        const float lr = LAMR[(t + 1) * 64 + p], li = LAMI[(t + 1) * 64 + p], cr = CR[c * 64 + p], ci = CI[c * 64 + p];
        const float val = ri == 0 ? (cr * lr - ci * li) : -(cr * li + ci * lr);
        TBg[(size_t)(t * 16 + c) * 640 + 512 + ri * 64 + p] = f2bf(val); }
    bf16_t* GTg = GT + (size_t)g * 256 * 512;
    for (int idx = tid; idx < 16384; idx += 512) {
        const int sc = idx & 511, s = sc >> 4, c1 = sc & 15, r = 32 * q + (idx >> 9), ri = r >> 6, p = r & 63;
        const float lr = LAMR[(31 - s) * 64 + p], li = LAMI[(31 - s) * 64 + p], br = BBR[p * 16 + c1], bi = BBI[p * 16 + c1];
        GTg[(size_t)r * 512 + sc] = f2bf(ri == 0 ? (lr * br - li * bi) : (lr * bi + li * br)); }
    for (int idx = tid; idx < 2048; idx += 512) {
        ((u32x4*)(GTg + (size_t)(128 + 32 * q) * 512))[idx] = (u32x4){0u, 0u, 0u, 0u}; }
    if (q == 0) {
        if (tid < 64) { f32x4 v; v[0] = LAMR[64 + tid]; v[1] = LAMI[64 + tid]; v[2] = LAMR[32 * 64 + tid]; v[3] = LAMI[32 * 64 + tid]; *(f32x4*)(LAMT + (size_t)(g * 64 + tid) * 4) = v; }
        for (int idx = tid; idx < 1024; idx += 512) { const int p = idx >> 4, c1 = idx & 15; *(f32x2*)(BBT + ((size_t)(g * 8 + (c1 >> 1)) * 64 + p) * 4 + (c1 & 1) * 2) = (f32x2){BBR[idx], BBI[idx]}; }
    }
    __syncthreads();
}

__device__ __forceinline__ void hgrn_pre_load(int item, const float* LF, const bf16_t* QB, const bf16_t* VB, float (&lf)[16], bf16_t (&qv)[16], bf16_t (&vv)[16], int tid) {
    const int bh = item >> 5, c = item & 31, b = bh >> 3, h = bh & 7, seg = tid >> 7, k = tid & 127;
    const size_t base = (size_t)(b * 2048 + c * 64 + seg * 16) * WA + h * 128 + k;
#pragma unroll
    for (int i = 0; i < 16; ++i) { lf[i] = __builtin_nontemporal_load(LF + base + (size_t)i * WA); qv[i] = __builtin_nontemporal_load(QB + base + (size_t)i * WA); vv[i] = __builtin_nontemporal_load(VB + base + (size_t)i * WA); }
}
__device__ __forceinline__ void hgrn_pre_compute(int item, const float (&lf)[16], const bf16_t (&qv)[16], const bf16_t (&vv)[16], bf16_t* PRE, float* DL, unsigned* cntp, LAS float* tot, int tid) {
    const int seg = tid >> 7, k = tid & 127;
    float pl[16]; float run = 0.f;
#pragma unroll
    for (int i = 0; i < 16; ++i) { run += lf[i]; pl[i] = run; }
    tot[seg * 128 + k] = run;
    BAR_LDS();
    float off = 0.f, bl = 0.f;
#pragma unroll
    for (int s = 0; s < 4; ++s) { const float t = tot[s * 128 + k]; if (s < seg) off += t; bl += t; }
    BAR_LDS();
    const __amdgpu_buffer_rsrc_t pr = __builtin_amdgcn_make_buffer_rsrc(PRE, 0, 64 * 1048576, 0x00020000); const unsigned pb = (unsigned)item * 65536u;
    float kh[16];
#pragma unroll
    for (int i = 0; i < 16; ++i) { const float bc = pl[i] + off, kk = 1.f - __expf(lf[i]);
        __builtin_amdgcn_raw_buffer_store_b16((short)f2bf(bf2f(qv[i]) * __expf(bc)), pr, pb + (unsigned)(((seg * 16 + i) * 128 + k) * 2), 0, 16);
        __builtin_amdgcn_raw_buffer_store_b16((short)f2bf(kk * __expf(-bc)), pr, pb + (unsigned)((8192 + (seg * 16 + i) * 128 + k) * 2), 0, 16); kh[i] = kk * __expf(bl - bc); }
    u32x4 w0, w1;
    w0.x = cvt_pk_bf16(kh[0], kh[1]); w0.y = cvt_pk_bf16(kh[2], kh[3]); w0.z = cvt_pk_bf16(kh[4], kh[5]); w0.w = cvt_pk_bf16(kh[6], kh[7]);
    w1.x = cvt_pk_bf16(kh[8], kh[9]); w1.y = cvt_pk_bf16(kh[10], kh[11]); w1.z = cvt_pk_bf16(kh[12], kh[13]); w1.w = cvt_pk_bf16(kh[14], kh[15]);
    __builtin_amdgcn_raw_buffer_store_b128(w0, pr, pb + (unsigned)((16384 + k * 64 + seg * 16) * 2), 0, 16); __builtin_amdgcn_raw_buffer_store_b128(w1, pr, pb + (unsigned)((16384 + k * 64 + seg * 16) * 2 + 16), 0, 16);
    w0.x = (unsigned)vv[0] | ((unsigned)vv[1] << 16); w0.y = (unsigned)vv[2] | ((unsigned)vv[3] << 16); w0.z = (unsigned)vv[4] | ((unsigned)vv[5] << 16); w0.w = (unsigned)vv[6] | ((unsigned)vv[7] << 16);
    w1.x = (unsigned)vv[8] | ((unsigned)vv[9] << 16); w1.y = (unsigned)vv[10] | ((unsigned)vv[11] << 16); w1.z = (unsigned)vv[12] | ((unsigned)vv[13] << 16); w1.w = (unsigned)vv[14] | ((unsigned)vv[15] << 16);
    __builtin_amdgcn_raw_buffer_store_b128(w0, pr, pb + (unsigned)((24576 + k * 64 + seg * 16) * 2), 0, 16); __builtin_amdgcn_raw_buffer_store_b128(w1, pr, pb + (unsigned)((24576 + k * 64 + seg * 16) * 2 + 16), 0, 16);
    if (seg == 0) __hip_atomic_store(DL + (size_t)item * 128 + k, __expf(bl), __ATOMIC_RELAXED, __HIP_MEMORY_SCOPE_AGENT);
    asm volatile("s_waitcnt vmcnt(0)" ::: "memory");
    if ((tid & 63) == 0) __hip_atomic_fetch_add(cntp + 16 * (item >> 3), 1u, __ATOMIC_RELAXED, __HIP_MEMORY_SCOPE_AGENT);
}

constexpr int CH_QT = 0, CH_KT = 17408, CH_KH = 34816, CH_VT = 53248, CH_P = 71680, CH_ST = 80896, CH_DL = 115712;
__device__ __forceinline__ bf16x8 ldfrag(const LAS unsigned char* base, int row, int stride, int kb) { return *(const LAS bf16x8*)(base + row * stride + kb); }
__device__ __forceinline__ void hgrn_chain(int b, int h, int seg, const bf16_t* PRE, const float* DL, float* ORAW, float* SLOC, float* DSEG, const unsigned* cntp, LAS unsigned char* lds, int tid) {
    const int lane = tid & 63, w = __builtin_amdgcn_readfirstlane(tid >> 6), l15 = lane & 15, lq = lane >> 4;
    f32x4 sacc[8];
#pragma unroll
    for (int i = 0; i < 8; ++i) sacc[i] = (f32x4){0.f, 0.f, 0.f, 0.f};
    for (int i = tid; i < 34816 / 16; i += 512) ((LAS u32x4*)(lds + CH_ST))[i] = (u32x4){0u, 0u, 0u, 0u};
    const int item0 = (b * 8 + h) * 32 + seg * 8, chunk0 = seg * 8;
    if (tid == 0) { const unsigned* wp = cntp + 16 * ((b * 8 + h) * 4 + seg); while (__hip_atomic_load(wp, __ATOMIC_RELAXED, __HIP_MEMORY_SCOPE_AGENT) < 64u) __builtin_amdgcn_s_sleep(4);
        __builtin_amdgcn_fence(__ATOMIC_ACQUIRE, "agent"); asm volatile("s_waitcnt vmcnt(0)" ::: "memory"); }
    __syncthreads();
    u32x4 pfA[8], pfB[8]; float dlA = 0.f, dlB = 0.f, dprod = 1.f;
#define CH_LOAD(PF, DLV, cc) do { const u32x4* src_ = (const u32x4*)(PRE + (size_t)(item0 + (cc)) * 32768); _Pragma("unroll") for (int j = 0; j < 8; ++j) PF[j] = src_[tid + 512 * j]; \
        if (tid < 128) DLV = DL[(size_t)(item0 + (cc)) * 128 + tid]; } while (0)
#define CH_STEP(PF, DLV, c) do { \
        _Pragma("unroll") for (int j = 0; j < 8; ++j) { const int pi = (tid + 512 * j) & 1023; int off; \
            if (j < 2) off = CH_QT + (pi >> 4) * 272 + (pi & 15) * 16; else if (j < 4) off = CH_KT + (pi >> 4) * 272 + (pi & 15) * 16; \
            else if (j < 6) off = CH_KH + (pi >> 3) * 144 + (pi & 7) * 16; else off = CH_VT + (pi >> 3) * 144 + (pi & 7) * 16; \
            *(LAS u32x4*)(lds + off) = PF[j]; } \
        if (tid < 128) { ((LAS float*)(lds + CH_DL))[tid] = DLV; dprod *= DLV; } \
        BAR_LDS();                                                                               \
        if ((c) + 2 < 8) CH_LOAD(PF, DLV, (c) + 2);                                               \
        { const int tt = w >> 1; \
          _Pragma("unroll") for (int e = 0; e < 2; ++e) { const int st = (w & 1) * 2 + e; f32x4 a = (f32x4){0.f, 0.f, 0.f, 0.f}; \
            _Pragma("unroll") for (int ks = 0; ks < 4; ++ks) a = __builtin_amdgcn_mfma_f32_16x16x32_bf16(ldfrag(lds + CH_KT, 16 * st + l15, 272, (ks * 32 + 8 * lq) * 2), ldfrag(lds + CH_QT, 16 * tt + l15, 272, (ks * 32 + 8 * lq) * 2), a, 0, 0, 0); \
            const int t = 16 * tt + l15, s0 = 16 * st + 4 * lq; \
            _Pragma("unroll") for (int j = 0; j < 4; ++j) a[j] = (s0 + j <= t) ? a[j] : 0.f; \
            *(LAS u32x2*)(lds + CH_P + t * 144 + s0 * 2) = (u32x2){cvt_pk_bf16(a[0], a[1]), cvt_pk_bf16(a[2], a[3])}; } } \
        BAR_LDS();                                                                               \
        bf16x8 aV[2], aS[4]; \
        _Pragma("unroll") for (int ss = 0; ss < 2; ++ss) aV[ss] = ldfrag(lds + CH_VT, 16 * w + l15, 144, (ss * 32 + 8 * lq) * 2); \
        _Pragma("unroll") for (int ks = 0; ks < 4; ++ks) aS[ks] = ldfrag(lds + CH_ST, 16 * w + l15, 272, (ks * 32 + 8 * lq) * 2); \
        const int tok0 = b * 2048 + (chunk0 + (c)) * 64; \
        _Pragma("unroll") for (int tt = 0; tt < 4; ++tt) { f32x4 a = (f32x4){0.f, 0.f, 0.f, 0.f}; \
            _Pragma("unroll") for (int ss = 0; ss < 2; ++ss) a = __builtin_amdgcn_mfma_f32_16x16x32_bf16(aV[ss], ldfrag(lds + CH_P, 16 * tt + l15, 144, (ss * 32 + 8 * lq) * 2), a, 0, 0, 0); \
            _Pragma("unroll") for (int ks = 0; ks < 4; ++ks) a = __builtin_amdgcn_mfma_f32_16x16x32_bf16(aS[ks], ldfrag(lds + CH_QT, 16 * tt + l15, 272, (ks * 32 + 8 * lq) * 2), a, 0, 0, 0); \
            *(f32x4*)(ORAW + (size_t)(tok0 + 16 * tt + l15) * WA + h * 128 + 16 * w + 4 * lq) = a; } \
        _Pragma("unroll") for (int kt = 0; kt < 8; ++kt) { const f32x4 d4 = *(const LAS f32x4*)(lds + CH_DL + (16 * kt + 4 * lq) * 4); sacc[kt] = sacc[kt] * d4; \
            _Pragma("unroll") for (int ss = 0; ss < 2; ++ss) sacc[kt] = __builtin_amdgcn_mfma_f32_16x16x32_bf16(ldfrag(lds + CH_KH, 16 * kt + l15, 144, (ss * 32 + 8 * lq) * 2), aV[ss], sacc[kt], 0, 0, 0); } \
        BAR_LDS();                                                                               \
        _Pragma("unroll") for (int kt = 0; kt < 8; ++kt) *(LAS u32x2*)(lds + CH_ST + (16 * w + l15) * 272 + (16 * kt + 4 * lq) * 2) = (u32x2){cvt_pk_bf16(sacc[kt][0], sacc[kt][1]), cvt_pk_bf16(sacc[kt][2], sacc[kt][3])}; \
    } while (0)
    CH_LOAD(pfA, dlA, 0); CH_LOAD(pfB, dlB, 1);
    for (int c = 0; c < 8; c += 2) { CH_STEP(pfA, dlA, c); CH_STEP(pfB, dlB, c + 1); }
#undef CH_LOAD
#undef CH_STEP
    {   float* sl = SLOC + (size_t)((b * 8 + h) * 4 + seg) * 16384;
#pragma unroll
        for (int kt = 0; kt < 8; ++kt)
#pragma unroll
            for (int j = 0; j < 1; ++j) ((f32x4*)sl)[(w * 8 + kt) * 64 + lane] = sacc[kt];
        if (tid < 128) DSEG[(size_t)((b * 8 + h) * 4 + seg) * 128 + tid] = dprod; }
    __syncthreads();
}

__device__ __forceinline__ void hgrn_corr(int b, int h, int seg, const bf16_t* PRE, const float* DL, const float* SLOC, const float* DSEG, float* ORAW, float* out_state, unsigned* cdone, LAS unsigned char* lds, int tid) {
    const int lane = tid & 63, w = __builtin_amdgcn_readfirstlane(tid >> 6), l15 = lane & 15, lq = lane >> 4, bh = b * 8 + h;
    f32x4 sacc[8];
#pragma unroll
    for (int i = 0; i < 8; ++i) sacc[i] = (f32x4){0.f, 0.f, 0.f, 0.f};
    for (int sp = 0; sp < seg; ++sp) {
        const float* sl = SLOC + (size_t)(bh * 4 + sp) * 16384; const float* dg = DSEG + (size_t)(bh * 4 + sp) * 128;
#pragma unroll
        for (int kt = 0; kt < 8; ++kt) { const f32x4 d4 = *(const f32x4*)(dg + 16 * kt + 4 * lq);
#pragma unroll
            for (int j = 0; j < 1; ++j) { const f32x4 sv = ((const f32x4*)sl)[(w * 8 + kt) * 64 + lane]; sacc[kt] = sacc[kt] * d4 + sv; } }
    }
    const int item0 = bh * 32 + seg * 8;
    u32x4 q0, q1; float dlv = 0.f;
    { const u32x4* src = (const u32x4*)(PRE + (size_t)item0 * 32768); q0 = src[tid]; q1 = src[tid + 512]; if (tid < 128) dlv = DL[(size_t)item0 * 128 + tid]; }
    f32x4 ov[4];
#pragma unroll
    for (int tt = 0; tt < 4; ++tt) ov[tt] = *(const f32x4*)(ORAW + (size_t)(b * 2048 + seg * 512 + 16 * tt + l15) * WA + h * 128 + 16 * w + 4 * lq);
    for (int c = 0; c < 8; ++c) {
        { const int p0 = tid, p1 = tid + 512; *(LAS u32x4*)(lds + CH_QT + (p0 >> 4) * 272 + (p0 & 15) * 16) = q0; *(LAS u32x4*)(lds + CH_QT + (p1 >> 4) * 272 + (p1 & 15) * 16) = q1;
          if (tid < 128) ((LAS float*)(lds + CH_DL))[tid] = dlv; }
#pragma unroll
        for (int kt = 0; kt < 8; ++kt) *(LAS u32x2*)(lds + CH_ST + (16 * w + l15) * 272 + (16 * kt + 4 * lq) * 2) = (u32x2){cvt_pk_bf16(sacc[kt][0], sacc[kt][1]), cvt_pk_bf16(sacc[kt][2], sacc[kt][3])};
        BAR_LDS();
        if (c + 1 < 8) { const u32x4* src = (const u32x4*)(PRE + (size_t)(item0 + c + 1) * 32768); q0 = src[tid]; q1 = src[tid + 512]; if (tid < 128) dlv = DL[(size_t)(item0 + c + 1) * 128 + tid]; }
        const int tok0 = b * 2048 + (seg * 8 + c) * 64;
        f32x4 ovn[4];
#pragma unroll
        for (int tt = 0; tt < 4; ++tt) ovn[tt] = (c + 1 < 8) ? *(const f32x4*)(ORAW + (size_t)(tok0 + 64 + 16 * tt + l15) * WA + h * 128 + 16 * w + 4 * lq) : (f32x4){0.f, 0.f, 0.f, 0.f};
        bf16x8 aS[4];
#pragma unroll
        for (int ks = 0; ks < 4; ++ks) aS[ks] = ldfrag(lds + CH_ST, 16 * w + l15, 272, (ks * 32 + 8 * lq) * 2);
#pragma unroll
        for (int tt = 0; tt < 4; ++tt) { f32x4 a = ov[tt];
#pragma unroll
            for (int ks = 0; ks < 4; ++ks) a = __builtin_amdgcn_mfma_f32_16x16x32_bf16(aS[ks], ldfrag(lds + CH_QT, 16 * tt + l15, 272, (ks * 32 + 8 * lq) * 2), a, 0, 0, 0);
            *(f32x4*)(ORAW + (size_t)(tok0 + 16 * tt + l15) * WA + h * 128 + 16 * w + 4 * lq) = a; }
#pragma unroll
        for (int kt = 0; kt < 8; ++kt) { const f32x4 d4 = *(const LAS f32x4*)(lds + CH_DL + (16 * kt + 4 * lq) * 4); sacc[kt] = sacc[kt] * d4; }
#pragma unroll
        for (int tt = 0; tt < 4; ++tt) ov[tt] = ovn[tt];
        BAR_LDS();
    }
    if (seg == 3 && out_state) {
        const float* sl = SLOC + (size_t)(bh * 4 + 3) * 16384;
#pragma unroll
        for (int kt = 0; kt < 8; ++kt)
#pragma unroll
            for (int j = 0; j < 4; ++j) out_state[((size_t)bh * 128 + 16 * kt + 4 * lq + j) * 128 + 16 * w + l15] = sacc[kt][j] + ((const f32x4*)sl)[(w * 8 + kt) * 64 + lane][j]; }
    __syncthreads();
    if (tid == 0) { __builtin_amdgcn_fence(__ATOMIC_RELEASE, "agent"); asm volatile("s_waitcnt vmcnt(0)" ::: "memory");
        __hip_atomic_fetch_add(cdone, 8u, __ATOMIC_RELAXED, __HIP_MEMORY_SCOPE_AGENT); }
    __syncthreads();
}

__device__ __forceinline__ void hgrn_sample_load(int bh, const float* LF, const bf16_t* QB, const bf16_t* VB, const float* s0, f32x4 (&S)[8], float& tf, bf16_t& tq, bf16_t& tv, int tid) {
    const int b = bh >> 3, h = bh & 7, v4 = tid & 31, kr = tid >> 5;
    { const int t = tid >> 7, k = tid & 127; const size_t rb = (size_t)(NPROMPT + b * 4 + t) * WA + h * 128 + k; tf = LF[rb]; tq = QB[rb]; tv = VB[rb]; }
#pragma unroll
    for (int i = 0; i < 8; ++i) S[i] = __builtin_nontemporal_load((const f32x4*)(s0 + ((size_t)bh * 128 + kr * 8 + i) * 128 + 4 * v4));
}
__device__ __forceinline__ void hgrn_sample_compute(int bh, f32x4 (&S)[8], float tf, bf16_t tq, bf16_t tv, float* ORAWS, float* out_state, LAS float* L, int tid) {
    const int b = bh >> 3, h = bh & 7, v4 = tid & 31, kr = tid >> 5;
    { const int t = tid >> 7, k = tid & 127; const float f = __expf(tf); L[(t * 3 + 0) * 128 + k] = f; L[(t * 3 + 1) * 128 + k] = 1.f - f; L[(t * 3 + 2) * 128 + k] = bf2f(tq); L[1536 + t * 128 + k] = bf2f(tv); }
    BAR_LDS();
#pragma unroll
    for (int t = 0; t < 4; ++t) {
        const f32x4 vv = *(const LAS f32x4*)(L + 1536 + t * 128 + 4 * v4); f32x4 po = (f32x4){0.f, 0.f, 0.f, 0.f};
        const f32x4 f0 = *(const LAS f32x4*)(L + (t * 3 + 0) * 128 + kr * 8), f1 = *(const LAS f32x4*)(L + (t * 3 + 0) * 128 + kr * 8 + 4), k0 = *(const LAS f32x4*)(L + (t * 3 + 1) * 128 + kr * 8), k1 = *(const LAS f32x4*)(L + (t * 3 + 1) * 128 + kr * 8 + 4),
                    q0 = *(const LAS f32x4*)(L + (t * 3 + 2) * 128 + kr * 8), q1 = *(const LAS f32x4*)(L + (t * 3 + 2) * 128 + kr * 8 + 4);
#pragma unroll
        for (int i = 0; i < 8; ++i) { const float f = i < 4 ? f0[i & 3] : f1[i & 3], kk = i < 4 ? k0[i & 3] : k1[i & 3], q = i < 4 ? q0[i & 3] : q1[i & 3];
            S[i] = S[i] * f + vv * kk; po += S[i] * q; }
        *(LAS f32x4*)(L + 2048 + (t * 16 + kr) * 128 + 4 * v4) = po;
    }
    BAR_LDS();
    { const int t = tid >> 7, v = tid & 127; float s = 0.f;
#pragma unroll
      for (int j = 0; j < 16; ++j) s += L[2048 + (t * 16 + j) * 128 + v];
      ORAWS[(size_t)(b * 4 + t) * WA + h * 128 + v] = s; }
    if (out_state) {
#pragma unroll
    for (int i = 0; i < 8; ++i) __builtin_nontemporal_store(S[i], (f32x4*)(out_state + ((size_t)bh * 128 + kr * 8 + i) * 128 + 4 * v4)); }
    BAR_LDS();
}

__device__ __forceinline__ void s5_scan(int g, const float* XLOC, const float* LAMT, bf16_t* UG, float* o_rp, float* o_ip, unsigned* cnts, int tid) {
    const __amdgpu_buffer_rsrc_t ur = __builtin_amdgcn_make_buffer_rsrc(UG, 0, 20 * 1048576, 0x00020000);
    if (tid < 256) { const int b = tid >> 6, p = tid & 63; const f32x4 lm = *(const f32x4*)(LAMT + (size_t)(g * 64 + p) * 4); const float l32r = lm[2], l32i = lm[3];
        float cr = 0.f, ci = 0.f;
        for (int cb = 0; cb < 4; ++cb) { float xr[16], xi[16];
#pragma unroll
            for (int i = 0; i < 16; ++i) { const size_t row = (size_t)g * 256 + b * 64 + cb * 16 + i; xr[i] = XLOC[row * 128 + p]; xi[i] = XLOC[row * 128 + 64 + p]; }
#pragma unroll
            for (int i = 0; i < 16; ++i) { const size_t row = (size_t)g * 256 + b * 64 + cb * 16 + i;
                __builtin_amdgcn_raw_buffer_store_b16((short)f2bf(cr), ur, (unsigned)((row * 640 + 512 + p) * 2), 0, 16); __builtin_amdgcn_raw_buffer_store_b16((short)f2bf(ci), ur, (unsigned)((row * 640 + 576 + p) * 2), 0, 16);
                const float nr = l32r * cr - l32i * ci + xr[i], ni = l32r * ci + l32i * cr + xi[i]; cr = nr; ci = ni; } }
        if (o_rp) o_rp[(size_t)(b * 64 + g) * 64 + p] = cr; if (o_ip) o_ip[(size_t)(b * 64 + g) * 64 + p] = ci; }
    asm volatile("s_waitcnt vmcnt(0)" ::: "memory");
    __syncthreads();
    if (tid == 0) __hip_atomic_fetch_add(cnts + 16 * g, 1u, __ATOMIC_RELAXED, __HIP_MEMORY_SCOPE_AGENT);
}

__device__ __forceinline__ void s5_sample_item(int item, const bf16_t* US, const float* LAMT, const float* BBT, const float* c_re, const float* c_im, const float* dd, const float* x0r, const float* x0i,
                                               bf16_t* YBUF, float* o_rs, float* o_is, LAS float* L, int tid) {
    const int g = item >> 4, b = (item & 15) * 8 + (tid >> 6), lane = tid & 63, wv = tid >> 6;
    LAS float* CRs = L; LAS float* CIs = L + 16 * 68; LAS float* XS = L + 2 * 16 * 68 + wv * 512;
    for (int idx = tid; idx < 1024; idx += 512) { const int c = idx >> 6, p = idx & 63; CRs[c * 68 + p] = c_re[g * 1024 + idx]; CIs[c * 68 + p] = c_im[g * 1024 + idx]; }
    const f32x4 lm = *(const f32x4*)(LAMT + (size_t)(g * 64 + lane) * 4);
    float xr = x0r[(size_t)(b * 64 + g) * 64 + lane], xi = x0i[(size_t)(b * 64 + g) * 64 + lane];
    float bbr[16], bbi[16];
#pragma unroll
    for (int c = 0; c < 16; c += 2) { const f32x4 v = *(const f32x4*)(BBT + ((size_t)(g * 8 + (c >> 1)) * 64 + lane) * 4); bbr[c] = v[0]; bbi[c] = v[1]; bbr[c + 1] = v[2]; bbi[c + 1] = v[3]; }
    float myu = 0.f;
#pragma unroll
    for (int t = 0; t < 4; ++t) {
        const u32x4* up = (const u32x4*)(US + (size_t)(b * 4 + t) * WA + g * 16); const u32x4 u0 = up[0], u1 = up[1];
        const float u[16] = {bf_lo(u0.x), bf_hi(u0.x), bf_lo(u0.y), bf_hi(u0.y), bf_lo(u0.z), bf_hi(u0.z), bf_lo(u0.w), bf_hi(u0.w), bf_lo(u1.x), bf_hi(u1.x), bf_lo(u1.y), bf_hi(u1.y), bf_lo(u1.z), bf_hi(u1.z), bf_lo(u1.w), bf_hi(u1.w)};
        float br = 0.f, bi = 0.f;
#pragma unroll
        for (int c = 0; c < 16; ++c) { br += bbr[c] * u[c]; bi += bbi[c] * u[c]; if ((lane >> 4) == t && (lane & 15) == c) myu = u[c]; }
        const float nr = lm[0] * xr - lm[1] * xi + br, ni = lm[0] * xi + lm[1] * xr + bi; xr = nr; xi = ni;
        XS[(t * 2 + 0) * 64 + lane] = xr; XS[(t * 2 + 1) * 64 + lane] = xi;
    }
    if (o_rs) o_rs[(size_t)(b * 64 + g) * 64 + lane] = xr; if (o_is) o_is[(size_t)(b * 64 + g) * 64 + lane] = xi;
    BAR_LDS();
    { const int t = lane >> 4, c = lane & 15; float y = 0.f;
#pragma unroll 4
      for (int p = 0; p < 64; p += 4) { const f32x4 cr = *(const LAS f32x4*)(CRs + c * 68 + p), ci = *(const LAS f32x4*)(CIs + c * 68 + p), xr4 = *(const LAS f32x4*)(XS + (t * 2) * 64 + p), xi4 = *(const LAS f32x4*)(XS + (t * 2 + 1) * 64 + p);
          y += (cr[0] * xr4[0] - ci[0] * xi4[0]) + (cr[1] * xr4[1] - ci[1] * xi4[1]) + (cr[2] * xr4[2] - ci[2] * xi4[2]) + (cr[3] * xr4[3] - ci[3] * xi4[3]); }
      y += dd[g * 16 + c] * myu;
      YBUF[(size_t)(NPROMPT + b * 4 + t) * WA + g * 16 + c] = f2bf(gelu_tanh_f(y)); }
    BAR_LDS();
}

__device__ __forceinline__ void gate_row(int tok, const float* ORAW, const float* ORAWS, const bf16_t* GB, const float* ng, bf16_t* MIX, int lane) {
    const float* orow = tok < NPROMPT ? ORAW + (size_t)tok * WA : ORAWS + (size_t)(tok - NPROMPT) * WA;
    f32x4 v[4]; float s = 0.f;
#pragma unroll
    for (int j = 0; j < 4; ++j) { v[j] = __builtin_nontemporal_load((const f32x4*)orow + lane + 64 * j); s += (v[j][0] * v[j][0] + v[j][1] * v[j][1]) + (v[j][2] * v[j][2] + v[j][3] * v[j][3]); }
    const float rstd = rsqrtf(wave_sum(s) * (1.f / WA) + 1e-6f);
#pragma unroll
    for (int j = 0; j < 4; ++j) { const f32x4 gv = ((const f32x4*)ng)[lane + 64 * j]; const u32x2 gw = ((const u32x2*)(GB + (size_t)tok * WA))[lane + 64 * j];
        const unsigned long long w = (unsigned long long)cvt_pk_bf16(v[j][0] * rstd * gv[0] * bf_lo(gw.x), v[j][1] * rstd * gv[1] * bf_hi(gw.x)) | ((unsigned long long)cvt_pk_bf16(v[j][2] * rstd * gv[2] * bf_lo(gw.y), v[j][3] * rstd * gv[3] * bf_hi(gw.y)) << 32);
        __hip_atomic_store((unsigned long long*)(MIX + (size_t)tok * DM) + lane + 64 * j, w, __ATOMIC_RELAXED, __HIP_MEMORY_SCOPE_AGENT); }
}

__device__ __forceinline__ void final_row(int tok, float* X1, const unsigned char* ws, const float* gf, int lane) {
    f32x4* xr = (f32x4*)(X1 + (size_t)tok * DM); f32x4 v[8]; float s = 0.f;
#pragma unroll
    for (int j = 0; j < 8; ++j) { v[j] = __builtin_nontemporal_load(xr + lane + 64 * j);
#pragma unroll
        for (int z = 0; z < 4; ++z) { const u32x2 pw = __builtin_nontemporal_load((const u32x2*)(ws + part_off(z, tok)) + lane + 64 * j); v[j][0] += bf_lo(pw.x); v[j][1] += bf_hi(pw.x); v[j][2] += bf_lo(pw.y); v[j][3] += bf_hi(pw.y); }
        s += (v[j][0] * v[j][0] + v[j][1] * v[j][1]) + (v[j][2] * v[j][2] + v[j][3] * v[j][3]); }
    const float rstd = rsqrtf(wave_sum(s) * (1.f / DM) + 1e-6f);
#pragma unroll
    for (int j = 0; j < 8; ++j) { const f32x4 gv = ((const f32x4*)gf)[lane + 64 * j]; __builtin_nontemporal_store((f32x4){v[j][0] * rstd * gv[0], v[j][1] * rstd * gv[1], v[j][2] * rstd * gv[2], v[j][3] * rstd * gv[3]}, xr + lane + 64 * j); }
}
constexpr int LDS_BYTES = 147456, NPH = 6;
struct Args { const float* in[24]; float* out; unsigned char* ws; int ph_lo, ph_hi, coop, omask; };

__global__ void __launch_bounds__(512, 2) mk(Args a) {
    extern __shared__ __attribute__((aligned(16))) unsigned char lds_raw[];
    LAS unsigned char* lds = (LAS unsigned char*)lds_raw;
    cg::grid_group grid = cg::this_grid();
    const int tid = threadIdx.x, lane = tid & 63, wave = __builtin_amdgcn_readfirstlane(tid >> 6), G = gridDim.x, blk = blockIdx.x;
    const int gw = blk * 8 + wave, NGW = G * 8;
    unsigned char* ws = a.ws; float* out = a.out;
    const float *x_p = a.in[0], *x_s = a.in[1];
    bf16_t* UG = (bf16_t*)(ws + WS_UG); float* XLOC = (float*)(ws + WS_XLOC); bf16_t* US = (bf16_t*)(ws + WS_US); bf16_t* WTDOWN = (bf16_t*)(ws + WS_WTDOWN);
    bf16_t* HB = (bf16_t*)(ws + WS_HB); bf16_t* YBUF = (bf16_t*)(ws + WS_YBUF); bf16_t* QB = (bf16_t*)(ws + WS_QB); bf16_t* VB = (bf16_t*)(ws + WS_VB); bf16_t* GB = (bf16_t*)(ws + WS_GB);
    float* LF = (float*)(ws + WS_LF); float* ORAW = LF; bf16_t* WTGLU = (bf16_t*)(ws + WS_WTGLU); bf16_t* WTOUT = (bf16_t*)(ws + WS_WTOUT); bf16_t* HH = (bf16_t*)(ws + WS_H);
    bf16_t* WTIN = (bf16_t*)(ws + WS_WTIN); bf16_t* PRE = (bf16_t*)(ws + WS_PRE); bf16_t* WTUP = (bf16_t*)(ws + WS_WTUP); bf16_t* A2 = (bf16_t*)(ws + WS_A2); bf16_t* TB = (bf16_t*)(ws + WS_TB);
    bf16_t* MIX = (bf16_t*)(ws + WS_MIX); bf16_t* GT = (bf16_t*)(ws + WS_GT); bf16_t* PART = (bf16_t*)(ws + WS_PART);
    float* SS2 = (float*)(ws + WS_SS2); float* LB = (float*)(ws + WS_LB); float* LAMT = (float*)(ws + WS_LAMT); float* BBT = (float*)(ws + WS_BBT); float* DL = (float*)(ws + WS_DL); float* ORAWS = (float*)(ws + WS_ORAWS); unsigned* CNT = (unsigned*)(ws + WS_CNT); unsigned* CNTP = (unsigned*)(ws + WS_CNTP); unsigned* CNTS = (unsigned*)(ws + WS_CNTS); float* SLOC = (float*)(ws + WS_SLOC); float* DSEG = (float*)(ws + WS_DSEG);
    float* X1 = out + O_YP;
    float* o_hp = (a.omask & 4) ? out + O_HP : nullptr; float* o_rp = (a.omask & 8) ? out + O_RP : nullptr; float* o_ip = (a.omask & 16) ? out + O_IP : nullptr;
    float* o_hs = (a.omask & 32) ? out + O_HS : nullptr; float* o_rs = (a.omask & 64) ? out + O_RS : nullptr; float* o_is = (a.omask & 128) ? out + O_IS : nullptr;
    const int lo = a.ph_lo, hi = a.ph_hi;
#ifdef PROBE_TS
    unsigned long long* ts = (unsigned long long*)(ws + WS_MISC + MiB + 768 * 1024);
#define TS(slot, cond) do { if (tid == 0 && (cond)) ts[slot] = __builtin_amdgcn_s_memrealtime(); } while (0)
#else
#define TS(slot, cond) do { } while (0)
#endif
    TS(0, blk == 0);
#define IN(k) (lo <= (k) && (k) < hi)
#define SEAM(k) do { if (IN(k) && IN((k) + 1) && a.coop) grid.sync(); TS((k) + 1, blk == 0); } while (0)

    if (IN(0)) {
        if (G < 256) for (int it = blk; it < 256; it += G) s5_table_item(it >> 2, it & 3, a.in[11], a.in[12], a.in[13], a.in[14], a.in[15], a.in[16], a.in[17], a.in[18], TB, GT, LAMT, BBT, (LAS float*)lds, tid);
        for (int i = blk * 512 + tid; i < NTOK; i += G * 512) SS2[i] = 0.f;
        for (int i = blk * 512 + tid; i < pg8::L_NLINES * 64; i += G * 512) CNT[i] = 0u;
        for (int i = blk * 512 + tid; i < 3072; i += G * 512) CNTP[i] = 0u;
        for (int i = blk * 512 + tid; i < WA; i += G * 512) { const float e0 = __expf(a.in[9][i]), e1 = __expf(a.in[9][WA + i]); LB[i] = e0 / (e0 + e1); }
        LAS float* scr = (LAS float*)(lds + wave * TR_WAVE_LDS);
        constexpr int I_IN = (DM / 64) * (INC / 64), I_GLU = (WA / 64) * (WA / 64), I_OUT = (DM / 64) * (DM / 64);
        unsigned* cntH = (unsigned*)(ws + WS_CNT1); unsigned* cntW = cntH + 64 * 34;
        for (int it = gw; it < I_IN + I_GLU; it += NGW) {
            if (it < I_IN) { transpose_item<true, true>(a.in[5], DM, INC, WTIN, scr, it, lane, nullptr);
                asm volatile("s_waitcnt vmcnt(0)" ::: "memory"); if (lane == 0) __hip_atomic_fetch_add(cntW + 64 * (it >> 7), 1u, __ATOMIC_RELAXED, __HIP_MEMORY_SCOPE_AGENT); }
            else transpose_item(a.in[19], WA, WA, WTGLU, scr, it - I_IN, lane, nullptr);
        }
        for (int r = gw; r < NTOK; r += NGW) { rms_row_bf16(r < NPROMPT ? x_p + (size_t)r * DM : x_s + (size_t)(r - NPROMPT) * DM, a.in[7], HB + (size_t)r * DM, lane);
            asm volatile("s_waitcnt vmcnt(0)" ::: "memory"); if (lane == 0) __hip_atomic_fetch_add(cntH + 64 * (r >> 8), 1u, __ATOMIC_RELAXED, __HIP_MEMORY_SCOPE_AGENT); }
        __syncthreads();
    }
    TS(1, blk == 0);
    if (IN(1)) {
        pg8::Gemm g{HB, WTIN, DM, DM, DM}; pg8::TileOrderDep S; S.init(NTOK, INC, 1, G, blk); S.cntH = (const unsigned*)(ws + WS_CNT1); S.cntW = S.cntH + 64 * 34;
        pg8::Epi1 E{ws, a.in[9]};
        pg8::gemm_phase<pg8::Epi1, pg8::TileOrderDep, true, true>(lds, g, S, E);
        __syncthreads();
        if (G >= 256) for (int it = blk - 168; it >= 0 && it < 256; it += G - 168) s5_table_item(it >> 2, it & 3, a.in[11], a.in[12], a.in[13], a.in[14], a.in[15], a.in[16], a.in[17], a.in[18], TB, GT, LAMT, BBT, (LAS float*)lds, tid);
    }
    SEAM(1);
    if (IN(2)) {
        { pg8::Gemm g{UG, GT, 512, 640, 512}; pg8::GroupOrder S{0, 64, 1, G, blk, (size_t)256 * 640, (size_t)256 * 512, 0}; pg8::EpiS1 E{XLOC};
          pg8::gemm_phase<pg8::EpiS1, pg8::GroupOrder, true, true>(lds, g, S, E); }
        __syncthreads(); TS(22, blk == 0);
        for (int gg = blk; gg < 64; gg += G) s5_scan(gg, XLOC, LAMT, UG, o_rp, o_ip, CNTS, tid);   TS(23, blk == 0);
        {
            int it, step, last;
            if (G == 256) { if (blk >= 64) { it = blk - 64; step = 192; last = 960; } else { it = 960 + blk; step = 1024; last = 1024; } } else { it = blk; step = G; last = 1024; }
            float lfA[16], lfB[16]; bf16_t qA[16], qB[16], vA[16], vB[16];
            if (it < last) hgrn_pre_load(it, LF, QB, VB, lfA, qA, vA, tid);
            while (it < last) { const int nx = it + step;
                if (nx < last) hgrn_pre_load(nx, LF, QB, VB, lfB, qB, vB, tid);
                hgrn_pre_compute(it, lfA, qA, vA, PRE, DL, CNTP, (LAS float*)lds, tid);
#pragma unroll
                for (int i = 0; i < 16; ++i) { lfA[i] = lfB[i]; qA[i] = qB[i]; vA[i] = vB[i]; }
                it = nx; }
        }
        __syncthreads();
    }
    TS(3, blk == 0);
    if (IN(3)) {
        int s0, per;
        if (blk < 128) { TS(16, blk == 0); if (!(a.omask & 256)) hgrn_chain(blk >> 5, (blk >> 2) & 7, blk & 3, PRE, DL, ORAW, SLOC, DSEG, CNTP, lds, tid); TS(17, blk == 0); s0 = blk * 4; per = 4; }
        else { const int j = blk - 128; s0 = 512 + j * 4; per = 4;
            if (!(a.omask & 512)) { const int g = j >> 1;
                if (tid == 0) { while (__hip_atomic_load(CNTS + 16 * g, __ATOMIC_RELAXED, __HIP_MEMORY_SCOPE_AGENT) < 1u) __builtin_amdgcn_s_sleep(4);
                    __builtin_amdgcn_fence(__ATOMIC_ACQUIRE, "agent"); asm volatile("s_waitcnt vmcnt(0)" ::: "memory"); }
                __syncthreads();
                pg8::Gemm gm{UG, TB, 640, 640, 640}; pg8::GroupOrder S{g, 1, 1, 1, 0, (size_t)256 * 640, (size_t)512 * 640, j & 1}; pg8::EpiS2 E{YBUF};
                pg8::gemm_phase<pg8::EpiS2, pg8::GroupOrder, true, true>(lds, gm, S, E); __syncthreads(); TS(18, blk == 128); } }
        if (!(a.omask & 1024)) {
            f32x4 SA[8], SB[8]; float fA = 0.f, fB = 0.f; bf16_t qA = 0, qB = 0, vA = 0, vB = 0;
            hgrn_sample_load(s0, LF, QB, VB, a.in[2], SA, fA, qA, vA, tid);
            for (int n = 0; n < per; ++n) {
                if (n + 1 < per) hgrn_sample_load(s0 + n + 1, LF, QB, VB, a.in[2], SB, fB, qB, vB, tid);
                hgrn_sample_compute(s0 + n, SA, fA, qA, vA, ORAWS, o_hs, (LAS float*)lds, tid);
#pragma unroll
                for (int i = 0; i < 8; ++i) SA[i] = SB[i];
                fA = fB; qA = qB; vA = vB; }
            TS(19, blk == 128); TS(20, blk == 0);
            for (int n = 0; n < per; ++n) s5_sample_item(s0 + n, US, LAMT, BBT, a.in[15], a.in[16], a.in[17], a.in[3], a.in[4], YBUF, o_rs, o_is, (LAS float*)lds, tid);
            TS(21, blk == 128); TS(24, blk == 0);
        }
        __syncthreads();
    }
    SEAM(3);
    if (IN(4)) {
        TS(14, blk == 2);
        if (blk < 96) { const int bh = blk / 3, sg = 1 + blk % 3; hgrn_corr(bh >> 3, bh & 7, sg, PRE, DL, SLOC, DSEG, ORAW, o_hp, CNT + 64 * pg8::L_CALL, lds, tid); TS(15, blk == 2); }
        else if (blk < 232) { pg8::Gemm g{YBUF, WTGLU, WA, WA, WA}; pg8::TileOrderPub S; S.init(NTOK, WA, 1, 136, blk - 96); S.cnt = CNT + 64 * pg8::L_CL; pg8::EpiGlu E{YBUF, a.in[20], MIX};
            pg8::gemm_phase<pg8::EpiGlu, pg8::TileOrderPub, true, true>(lds, g, S, E); }
        __syncthreads();
        constexpr int I_UP = (DM / 64) * (DFF / 64), I_DN = (DFF / 64) * (DM / 64), I_WO = (DM / 64) * (DM / 64);
        LAS float* scr = (LAS float*)(lds + wave * TR_WAVE_LDS);
        const int ncw = (G - 96) * 8, cw = (blk - 96) * 8 + wave;
#define COPY_WO_WD() do { for (int it = ncw - 1 - cw; it < I_WO + I_DN; it += ncw) { \
            if (it < I_WO) { transpose_item<true, true>(a.in[6], DM, DM, WTOUT, scr, it, lane, nullptr); \
                asm volatile("s_waitcnt vmcnt(0)" ::: "memory"); if (lane == 0) __hip_atomic_fetch_add(CNT + 64 * (pg8::L_WO + (it >> 7)), 1u, __ATOMIC_RELAXED, __HIP_MEMORY_SCOPE_AGENT); } \
            else { const int id = it - I_WO; transpose_item<true, true>(a.in[22], DFF, DM, WTDOWN, scr, id, lane, nullptr); \
                asm volatile("s_waitcnt vmcnt(0)" ::: "memory"); if (lane == 0) __hip_atomic_fetch_add(CNT + 64 * (pg8::L_WD + (id >> 9)), 1u, __ATOMIC_RELAXED, __HIP_MEMORY_SCOPE_AGENT); } } } while (0)
        if (blk >= 96) COPY_WO_WD();
        __syncthreads();
        if (tid == 0) { while (__hip_atomic_load(CNT + 64 * pg8::L_CALL, __ATOMIC_RELAXED, __HIP_MEMORY_SCOPE_AGENT) < 96u * 8u) __builtin_amdgcn_s_sleep(4);
            __builtin_amdgcn_fence(__ATOMIC_ACQUIRE, "agent"); asm volatile("s_waitcnt vmcnt(0)" ::: "memory"); }
        __syncthreads();
        for (int r = gw; r < NTOK; r += NGW) { gate_row(r, ORAW, ORAWS, GB, a.in[10], MIX, lane);
            asm volatile("s_waitcnt vmcnt(0)" ::: "memory"); if (lane == 0) __hip_atomic_fetch_add(CNT + 64 * (pg8::L_CG + (r >> 8)), 1u, __ATOMIC_RELAXED, __HIP_MEMORY_SCOPE_AGENT); }
        if (lane == 0) __hip_atomic_fetch_add(CNT + 64 * pg8::L_TOT, 1u, __ATOMIC_RELAXED, __HIP_MEMORY_SCOPE_AGENT);
#undef COPY_WO_WD
        if (blk >= 96) for (int iu = cw; iu < I_UP; iu += ncw) { transpose_item<true, true>(a.in[21], DM, DFF, WTUP, scr, iu, lane, a.in[8]);
            asm volatile("s_waitcnt vmcnt(0)" ::: "memory"); if (lane == 0) __hip_atomic_fetch_add(CNT + 64 * (pg8::L_WU + (iu >> 7)), 1u, __ATOMIC_RELAXED, __HIP_MEMORY_SCOPE_AGENT); }
        __syncthreads(); }
    TS(5, blk == 0);
    if (IN(5)) {
        { pg8::Gemm g{MIX, WTOUT, DM, DM, DM}; pg8::FfnOrder S{3, G, (blk + G - 232) % G, CNT, (unsigned)NGW}; pg8::EpiOut E{x_p, x_s, X1, A2, SS2};
          pg8::gemm_phase<pg8::EpiOut, pg8::FfnOrder, true, true>(lds, g, S, E); }
        TS(10, blk == 0);
        { pg8::Gemm g{A2, WTUP, DM, DM, DM}; pg8::FfnOrder S{4, G, (blk + G - 96) % G, CNT, (unsigned)NGW}; pg8::EpiUp E{SS2, HH};
          pg8::gemm_phase<pg8::EpiUp, pg8::FfnOrder, true, true>(lds, g, S, E); }
        TS(11, blk == 0);
        { pg8::Gemm g{HH, WTDOWN, DM, DFF, DFF}; pg8::FfnOrder S{6, G, (blk + G - 160) % G, CNT, (unsigned)NGW}; pg8::EpiDown E{ws};
          pg8::gemm_phase<pg8::EpiDown, pg8::FfnOrder, true, true>(lds, g, S, E); }
        TS(12, blk == 0);
        for (int r0 = blk * 8; r0 < NTOK; r0 += NGW) {
            if (tid == 0) { const unsigned* wd = CNT + 64 * (pg8::L_CP + (r0 >> 8));
                while (__hip_atomic_load(wd, __ATOMIC_RELAXED, __HIP_MEMORY_SCOPE_AGENT) < 256u) __builtin_amdgcn_s_sleep(4);
                __builtin_amdgcn_fence(__ATOMIC_ACQUIRE, "agent"); asm volatile("s_waitcnt vmcnt(0)" ::: "memory"); }
            __syncthreads();
            final_row(r0 + wave, X1, ws, a.in[23], lane); }
        __syncthreads(); TS(13, blk == 0);
    }
#ifdef PROBE_TS
    if (a.coop && blk == 0 && tid == 0) {
        const unsigned long long dt = ts[PROBE_B] - ts[PROBE_A], t0 = __builtin_amdgcn_s_memrealtime();
        while (__builtin_amdgcn_s_memrealtime() - t0 < dt * PROBE_AMP) __builtin_amdgcn_s_sleep(8); }
#endif
#undef IN
#undef SEAM
}

static int mk_grid = 0;
static void mk_setup() {
    if (mk_grid) return;
    int dev = 0, cus = 0, per_cu = 0;
    (void)hipGetDevice(&dev); (void)hipDeviceGetAttribute(&cus, hipDeviceAttributeMultiprocessorCount, dev);
    (void)hipFuncSetAttribute((const void*)mk, hipFuncAttributeMaxDynamicSharedMemorySize, LDS_BYTES);
    (void)hipOccupancyMaxActiveBlocksPerMultiprocessor(&per_cu, (const void*)mk, 512, LDS_BYTES);
    (void)hipGetLastError();
    mk_grid = cus > 0 ? cus : 256;
    fprintf(stderr, "mk_setup: cus %d per_cu %d grid %d\n", cus, per_cu, mk_grid);
}
static void mk_launch(void* const* d_in, void* d_out, void* d_ws, hipStream_t stream, int lo, int hi, int coop, int omask) {
    mk_setup();
    Args a{};
    for (int i = 0; i < 24; ++i) a.in[i] = (const float*)d_in[i];
    a.out = (float*)d_out; a.ws = (unsigned char*)d_ws; a.ph_lo = lo; a.ph_hi = hi; a.coop = coop; a.omask = omask;
    void* args[] = {&a};
    hipError_t e;
    if (coop) (void)hipMemsetAsync((unsigned char*)d_ws + WS_CNT1, 0, 54 * 256, stream);
    if (coop) e = hipLaunchCooperativeKernel((const void*)mk, dim3(mk_grid), dim3(512), args, LDS_BYTES, stream);
    else { hipLaunchKernelGGL(mk, dim3(mk_grid), dim3(512), LDS_BYTES, stream, a); e = hipPeekAtLastError(); }
    if (e != hipSuccess) fprintf(stderr, "mk launch failed: %s (grid %d, phases %d..%d)\n", hipGetErrorString(e), mk_grid, lo, hi);
}
extern "C" void kernel_launch(void* const* d_in, const int* in_sizes, int n_in, void* d_out, int out_size, void* d_ws, size_t ws_size, hipStream_t stream) {
    if (ws_size < WS_END || n_in < 24) { fprintf(stderr, "kernel_launch: ws %zu < %zu or n_in %d < 24; nothing launched\n", ws_size, (size_t)WS_END, n_in); return; }
#ifdef PROBE_MASK
#ifndef PROBE_SKIP
#define PROBE_SKIP 0
#endif
    for (int k = 0; k < NPH; ++k) if ((PROBE_MASK >> k) & 1) mk_launch(d_in, d_out, d_ws, stream, k, k + 1, 0, PROBE_SKIP);
#endif
    mk_launch(d_in, d_out, d_ws, stream, 0, NPH, 1, 0xFF);
}
```

```cpp
#include <hip/hip_runtime.h>
#include <hip/hip_cooperative_groups.h>
#include <cstdio>
#include <cstdint>
namespace cg = cooperative_groups;

#define LAS __attribute__((address_space(3)))
typedef unsigned short bf16_t;
typedef short bf16x8 __attribute__((ext_vector_type(8)));
typedef float f32x4 __attribute__((ext_vector_type(4)));
typedef float f32x2 __attribute__((ext_vector_type(2)));
typedef unsigned u32x4 __attribute__((ext_vector_type(4)));
typedef unsigned u32x2 __attribute__((ext_vector_type(2)));

typedef __bf16 bf16x2_t __attribute__((ext_vector_type(2)));
__device__ __forceinline__ unsigned cvt_pk_bf16(float lo, float hi) { const f32x2 v = {lo, hi}; return __builtin_bit_cast(unsigned, __builtin_convertvector(v, bf16x2_t)); }
__device__ __forceinline__ float bf_lo(unsigned w) { return __uint_as_float(w << 16); }
__device__ __forceinline__ float bf_hi(unsigned w) { return __uint_as_float(w & 0xffff0000u); }
__device__ __forceinline__ float bf2f(bf16_t v) { return __uint_as_float(((unsigned)v) << 16); }
__device__ __forceinline__ bf16_t f2bf(float f) { return (bf16_t)(cvt_pk_bf16(f, 0.f) & 0xffffu); }
__device__ __forceinline__ float sigm_f(float v) { return __builtin_amdgcn_rcpf(1.f + __expf(-v)); }
__device__ __forceinline__ float silu_f(float v) { return v * __builtin_amdgcn_rcpf(1.f + __expf(-v)); }
__device__ __forceinline__ float gelu_tanh_f(float v) { const float u = 1.5957691216057308f * (v + 0.044715f * v * v * v); return v * __builtin_amdgcn_rcpf(1.f + __expf(-u)); }
__device__ __forceinline__ float wave_sum(float v) {
#pragma unroll
    for (int o = 1; o < 64; o <<= 1) v += __shfl_xor(v, o);
    return v;
}
#define LDS_WAIT() asm volatile("s_waitcnt lgkmcnt(0)" ::: "memory")
#define BAR_LDS() do { asm volatile("s_waitcnt lgkmcnt(0)" ::: "memory"); __builtin_amdgcn_s_barrier(); asm volatile("" ::: "memory"); } while (0)

constexpr int NTOK = 8704, NPROMPT = 8192, DM = 2048, DFF = 8192, INC = 5120, WA = 1024;
constexpr size_t MiB = 1048576;
constexpr size_t WS_UG = 0, WS_XLOC = 20 * MiB, WS_US = 28 * MiB, WS_WTDOWN = 0;
constexpr size_t WS_HB = 32 * MiB, WS_YBUF = 32 * MiB, WS_QB = 66 * MiB, WS_VB = 83 * MiB, WS_GB = 100 * MiB, WS_LF = 117 * MiB, WS_WTGLU = 151 * MiB, WS_WTOUT = 268 * MiB  , WS_H = 32 * MiB;
constexpr size_t WS_WTIN = 168 * MiB, WS_PRE = 168 * MiB, WS_WTUP = 168 * MiB, WS_A2 = 200 * MiB, WS_TB = 234 * MiB, WS_MIX = 234 * MiB, WS_GT = 274 * MiB, WS_PART = 168 * MiB;
constexpr size_t WS_SLOC = 50 * MiB;
constexpr size_t WS_MISC = 304 * MiB, WS_DSEG = WS_MISC + 768 * 1024, WS_CNT = WS_MISC + 832 * 1024  , WS_CNT1 = WS_MISC + 928 * 1024  , WS_CNTP = WS_MISC + 944 * 1024  , WS_CNTS = WS_MISC + 952 * 1024  , WS_BAR = WS_MISC + 960 * 1024  , WS_SS2 = WS_MISC, WS_LB = WS_MISC + 65536, WS_LAMT = WS_MISC + 131072, WS_BBT = WS_MISC + 262144, WS_DL = WS_MISC + MiB, WS_ORAWS = WS_MISC + 2 * MiB, WS_PARTS = 308 * MiB  , WS_END = 316 * MiB;
__device__ __forceinline__ size_t part_off(int z, int row) {
    const size_t base = z == 0 ? 234 * MiB : (z == 1 ? 268 * MiB : (z == 2 ? 168 * MiB : 200 * MiB));
    return row < NPROMPT ? base + (size_t)row * 4096 : WS_PARTS + (size_t)z * 2 * MiB + (size_t)(row - NPROMPT) * 4096;
}
constexpr size_t O_YP = 0, O_HP = 17825792, O_RP = 18350080, O_IP = 18366464, O_HS = 18382848, O_RS = 35160064, O_IS = 35684352;

__device__ __forceinline__ void grid_bar(unsigned* cnt, unsigned target, int tid) {
    __syncthreads();
    if (tid == 0) {
        __builtin_amdgcn_fence(__ATOMIC_RELEASE, "agent");
        asm volatile("s_waitcnt vmcnt(0)" ::: "memory");
        __hip_atomic_fetch_add(cnt, 1u, __ATOMIC_RELAXED, __HIP_MEMORY_SCOPE_AGENT);
        while (__hip_atomic_load(cnt, __ATOMIC_RELAXED, __HIP_MEMORY_SCOPE_AGENT) < target) __builtin_amdgcn_s_sleep(1);
    }
    __syncthreads();
    __builtin_amdgcn_fence(__ATOMIC_ACQUIRE, "agent");
}

__device__ __forceinline__ void wait_lines_acquire(const unsigned* c, int n, unsigned need, int tid) {
    if (tid < n) while (__hip_atomic_load(c + 64 * tid, __ATOMIC_RELAXED, __HIP_MEMORY_SCOPE_AGENT) < need) __builtin_amdgcn_s_sleep(2);
    __syncthreads();
    __builtin_amdgcn_fence(__ATOMIC_ACQUIRE, "agent");
    asm volatile("s_waitcnt vmcnt(0)" ::: "memory");
    __syncthreads();
}
namespace pg8 {
#define PG8_LAS __attribute__((address_space(3)))
constexpr int BM = 256, BK = 64, HALF = 128, HTB = HALF * BK * 2  , STAGE_BYTES = 8 * HTB, NXCD = 8, WGM = 8;
__host__ __device__ __forceinline__ int lds_byte(int r, int c) { const int st = (r >> 4) * 2 + (c >> 5), rr = r & 15, cc = c & 31, ob = rr * 64 + cc * 2; return st * 1024 + (ob ^ (((ob >> 9) & 1) << 5)); }
__host__ __device__ __forceinline__ void stage_rc(int b, int& R, int& C) { const int st = b / 1024, sb = b % 1024, swz = sb ^ (((sb >> 9) & 1) << 5); R = (st >> 1) * 16 + swz / 64; C = (st & 1) * 32 + (swz % 64) / 2; }
__host__ __device__ __forceinline__ int perm32(int rho) { const int n = rho >> 4, i = rho & 15; return 8 * (i >> 2) + 4 * n + (i & 3); }
struct Unit { int pm, pn, z; };
struct Gemm { const bf16_t* A; const bf16_t* Bt; int K, lda, ldb; };

struct TileOrder {
    int nM, nN, nwg, nZ, G, c;
    __device__ __forceinline__ void init(int M, int N, int nZ_, int G_, int c_) { nM = M / BM; nN = N / BM; nwg = nM * nN; nZ = nZ_; G = G_; c = c_; }
    __device__ __forceinline__ bool next(int i, Unit& u) const {
        const long L = (long)i * G + c; if (L >= (long)nwg * nZ) return false;
        u.z = (int)(L / nwg); int wgid = (int)(L % nwg); { const int q = nwg / NXCD, r = nwg % NXCD, xcd = wgid % NXCD, off = wgid / NXCD; wgid = (xcd < r ? xcd * (q + 1) : r * (q + 1) + (xcd - r) * q) + off; }
        const int nig = WGM * nN, gid = wgid / nig, fm = gid * WGM, gsz = (nM - fm) < WGM ? (nM - fm) : WGM;
        u.pm = fm + ((wgid % nig) % gsz); u.pn = (wgid % nig) / gsz; return true;
    }
    __device__ __forceinline__ const char* a_base(const Gemm& g, const Unit& u) const { return (const char*)(g.A + (size_t)u.pm * BM * g.lda + (size_t)u.z * g.K); }
    __device__ __forceinline__ const char* b_base(const Gemm& g, const Unit& u) const { return (const char*)(g.Bt + (size_t)u.pn * BM * g.ldb + (size_t)u.z * g.K); }
    __device__ __forceinline__ void a_ready(const Unit&) const {}
    __device__ __forceinline__ void done(const Unit&) const {}
};
struct GroupOrder {
    int g0, ng, npn, G, c; size_t a_gstride, b_gstride; int pn0;
    __device__ __forceinline__ bool next(int i, Unit& u) const { const int per = i / npn, gi = per * G + c; if (gi >= ng) return false; u.pm = 0; u.pn = pn0 + i % npn; u.z = g0 + gi; return true; }
    __device__ __forceinline__ const char* a_base(const Gemm& g, const Unit& u) const { return (const char*)(g.A + (size_t)u.z * a_gstride); }
    __device__ __forceinline__ const char* b_base(const Gemm& g, const Unit& u) const { return (const char*)(g.Bt + (size_t)u.z * b_gstride + (size_t)u.pn * BM * g.ldb); }
    __device__ __forceinline__ void a_ready(const Unit&) const {}
    __device__ __forceinline__ void done(const Unit&) const {}
};

constexpr int L_C3 = 0, L_C4 = 34, L_CP = 170, L_CG = 204, L_WO = 238, L_WU = 246, L_TOT = 278, L_WD = 279, L_P3ALL = 287, L_P4ALL = 288, L_CALL = 289  , L_CL = 290  , L_GALL = 324  , L_NLINES = 325;
struct FfnOrder {
    int kind, G, c; unsigned* C; unsigned ntot;
    __device__ __forceinline__ bool next(int i, Unit& u) const {
        const int L = i * G + c;
        if (kind == 3) { if (L >= 272) return false; u.z = 0; if (L < 256) { u.pn = L & 7; u.pm = L >> 3; } else { u.pm = 32 + ((L - 256) >> 3); u.pn = L & 7; } return true; }
        if (L >= 1088) return false;
        if (kind == 4) { u.z = 0;
            if (L < 1024) { const int r = L >> 8, j = L & 255, x = j & 7, slot = j >> 3; u.pm = 8 * r + (slot >> 2); u.pn = 4 * x + (slot & 3); }
            else { const int l = L - 1024; u.pm = 32 + (l >> 5); u.pn = l & 31; }
            return true; }
        const int hf = L >= 544 ? 1 : 0, l = L - 544 * hf;
        if (l < 512) { const int r = l >> 7, j = l & 127, x = j & 7, slot = j >> 3; u.z = 2 * hf + (x & 1); u.pn = 4 * ((x >> 1) & 1) + (slot & 3); u.pm = 8 * r + 4 * (x >> 2) + (slot >> 2); }
        else { const int s = l - 512; u.pm = 32 + (s >> 4); u.z = 2 * hf + ((s >> 3) & 1); u.pn = s & 7; }
        return true;
    }
    __device__ __forceinline__ const char* a_base(const Gemm& g, const Unit& u) const { return (const char*)(g.A + (size_t)u.pm * BM * g.lda + (size_t)u.z * g.K); }
    __device__ __forceinline__ const char* b_base(const Gemm& g, const Unit& u) const { return (const char*)(g.Bt + (size_t)u.pn * BM * g.ldb + (size_t)u.z * g.K); }
    static __device__ __forceinline__ void spin(const unsigned* w, unsigned need) { while ((unsigned)__builtin_amdgcn_readfirstlane(__hip_atomic_load(w, __ATOMIC_RELAXED, __HIP_MEMORY_SCOPE_AGENT)) < need) __builtin_amdgcn_s_sleep(2); }
    __device__ __forceinline__ void a_ready(const Unit& u) const {
        if (threadIdx.x < 64) {
            if (kind == 3) { spin(C + 64 * (L_CG + u.pm), 256u); spin(C + 64 * (L_CL + u.pm), 32u); spin(C + 64 * (L_WO + u.pn), 128u); }
            else if (kind == 4) { spin(C + 64 * (L_C3 + u.pm), 64u); spin(C + 64 * (L_WU + u.pn), 128u); spin(C + 64 * L_TOT, ntot); spin(C + 64 * L_GALL, 1088u); }
            else { spin(C + 64 * (L_C4 + u.pm * 4 + u.z), 64u); spin(C + 64 * (L_WD + u.pn), 512u);
                if (u.z == 1) spin(C + 64 * L_P3ALL, 2176u);
                if (u.z >= 2) spin(C + 64 * L_P4ALL, 8704u); }
            __builtin_amdgcn_fence(__ATOMIC_ACQUIRE, "agent");
            asm volatile("s_waitcnt vmcnt(0)" ::: "memory");
        }
        asm volatile("" ::: "memory"); __builtin_amdgcn_s_barrier(); asm volatile("" ::: "memory");
    }
    __device__ __forceinline__ void done(const Unit& u) const {
        asm volatile("s_waitcnt vmcnt(0)" ::: "memory");
        if ((threadIdx.x & 63) == 0) {
            if (kind == 3) { __hip_atomic_fetch_add(C + 64 * (L_C3 + u.pm), 1u, __ATOMIC_RELAXED, __HIP_MEMORY_SCOPE_AGENT); __hip_atomic_fetch_add(C + 64 * L_P3ALL, 1u, __ATOMIC_RELAXED, __HIP_MEMORY_SCOPE_AGENT); }
            else if (kind == 4) { __hip_atomic_fetch_add(C + 64 * (L_C4 + u.pm * 4 + (u.pn >> 3)), 1u, __ATOMIC_RELAXED, __HIP_MEMORY_SCOPE_AGENT); __hip_atomic_fetch_add(C + 64 * L_P4ALL, 1u, __ATOMIC_RELAXED, __HIP_MEMORY_SCOPE_AGENT); }
            else __hip_atomic_fetch_add(C + 64 * (L_CP + u.pm), 1u, __ATOMIC_RELAXED, __HIP_MEMORY_SCOPE_AGENT);
        }
    }
};

struct TileOrderPub : TileOrder {
    unsigned* cnt;
    __device__ __forceinline__ void done(const Unit& u) const {
        asm volatile("s_waitcnt vmcnt(0)" ::: "memory");
        if ((threadIdx.x & 63) == 0) { __hip_atomic_fetch_add(cnt + 64 * u.pm, 1u, __ATOMIC_RELAXED, __HIP_MEMORY_SCOPE_AGENT); __hip_atomic_fetch_add(cnt + 64 * 34, 1u, __ATOMIC_RELAXED, __HIP_MEMORY_SCOPE_AGENT); }
    }
};
struct TileOrderDep : TileOrder {
    const unsigned* cntH; const unsigned* cntW;
    __device__ __forceinline__ void a_ready(const Unit& u) const {
        if (threadIdx.x < 64) {
            while ((unsigned)__builtin_amdgcn_readfirstlane(__hip_atomic_load(cntH + 64 * u.pm, __ATOMIC_RELAXED, __HIP_MEMORY_SCOPE_AGENT)) < 256u) __builtin_amdgcn_s_sleep(2);
            while ((unsigned)__builtin_amdgcn_readfirstlane(__hip_atomic_load(cntW + 64 * u.pn, __ATOMIC_RELAXED, __HIP_MEMORY_SCOPE_AGENT)) < 128u) __builtin_amdgcn_s_sleep(2);
            __builtin_amdgcn_fence(__ATOMIC_ACQUIRE, "agent");
            asm volatile("s_waitcnt vmcnt(0)" ::: "memory");
        }
        asm volatile("" ::: "memory"); __builtin_amdgcn_s_barrier(); asm volatile("" ::: "memory");
    }
};
template <class Epi, class Sched, bool ALIGN_EPI = false, bool SP2 = false, int AUXA = 0  >
__device__ __forceinline__ void gemm_phase(PG8_LAS unsigned char* lds, const Gemm g, const Sched& S, const Epi& E) {
    const int tid = threadIdx.x, wid = __builtin_amdgcn_readfirstlane(tid >> 6), lane = tid & 63, wr = wid >> 2, wc = wid & 3, fr = lane & 15, fq = lane >> 4;
    const int K = g.K, nt = K / BK, lda = g.lda, ldb = g.ldb;
    unsigned voffA[2], voffB[2];
#pragma unroll
    for (int i = 0; i < 2; ++i) { int R, C; stage_rc(tid * 16 + i * 8192, R, C); const int Rb = Epi::PERM ? ((R & ~31) + perm32(R & 31)) : R;
        voffA[i] = (unsigned)(R * lda + C) * 2u; voffB[i] = (unsigned)(Rb * ldb + C) * 2u; }
    const size_t kstep = (size_t)(BK * 2);
    const size_t hstepA = (size_t)HALF * lda * 2, hstepB = (size_t)HALF * ldb * 2;
    const unsigned ldsw = (unsigned)wid * 1024u;
    const int aoff = lds_byte(wr * 64 + fr, fq * 8), boff = lds_byte(wc * 32 + fr, fq * 8);
#define PG8_SA(b, h) (((b) * 2 + (h)) * HTB)
#define PG8_SB(b, h) ((4 + (b) * 2 + (h)) * HTB)
#define PG8_STAGE_X(bufoff, gbase, voff, AUX) do { _Pragma("unroll") for (int _i = 0; _i < 2; ++_i) \
        __builtin_amdgcn_global_load_lds((const unsigned*)((const char*)(gbase) + (voff)[_i]), (PG8_LAS unsigned*)(lds + (bufoff) + ldsw + _i * 8192), 16, 0, AUX); } while (0)
#define PG8_STAGE(bufoff, gbase, voff) PG8_STAGE_X(bufoff, gbase, voff, 0)
#define PG8_STAGEA(bufoff, gbase, voff) PG8_STAGE_X(bufoff, gbase, voff, AUXA)
#define PG8_LDA(dst, b, h) do { _Pragma("unroll") for (int m = 0; m < 4; ++m) _Pragma("unroll") for (int k = 0; k < 2; ++k) dst[m][k] = *(const PG8_LAS bf16x8*)(lds + PG8_SA(b, h) + aoff + m * 2048 + k * 1024); } while (0)
#define PG8_LDB(dst, b, h) do { _Pragma("unroll") for (int n = 0; n < 2; ++n) _Pragma("unroll") for (int k = 0; k < 2; ++k) dst[n][k] = *(const PG8_LAS bf16x8*)(lds + PG8_SB(b, h) + boff + n * 2048 + k * 1024); } while (0)
#define PG8_MMA(ai, bj, At, Bt) do { __builtin_amdgcn_s_setprio(1); _Pragma("unroll") for (int m = 0; m < 4; ++m) _Pragma("unroll") for (int n = 0; n < 2; ++n) _Pragma("unroll") for (int k = 0; k < 2; ++k) \
        acc[ai][bj][m][n] = __builtin_amdgcn_mfma_f32_16x16x32_bf16(Bt[n][k], At[m][k], acc[ai][bj][m][n], 0, 0, 0); __builtin_amdgcn_s_setprio(0); } while (0)
#define PG8_WAIT_V(n) asm volatile("s_waitcnt vmcnt(" #n ")" ::: "memory")
#define PG8_WAIT_L(n) asm volatile("s_waitcnt lgkmcnt(" #n ")" ::: "memory")
#define PG8_BAR __builtin_amdgcn_s_barrier()
#define PG8_SCHED __builtin_amdgcn_sched_barrier(0)
    Unit cur, nxt; int ui = 0;
    if (!S.next(0, cur)) return;
    f32x4 acc[2][2][4][2];
#pragma unroll
    for (int a = 0; a < 2; ++a)
#pragma unroll
        for (int b = 0; b < 2; ++b)
#pragma unroll
            for (int m = 0; m < 4; ++m)
#pragma unroll
                for (int n = 0; n < 2; ++n) acc[a][b][m][n] = (f32x4){0.f, 0.f, 0.f, 0.f};
    bf16x8 At[4][2], B0[2][2], B1[2][2];
    const char* cA = S.a_base(g, cur); const char* cB = S.b_base(g, cur);
    S.a_ready(cur);
    if constexpr (SP2) {
        PG8_STAGE(PG8_SB(0, 0), cB, voffB); PG8_STAGE(PG8_SB(0, 1), cB + hstepB, voffB); PG8_STAGEA(PG8_SA(0, 0), cA, voffA); PG8_STAGEA(PG8_SA(0, 1), cA + hstepA, voffA);
        if (wr == 1) PG8_BAR;
        PG8_WAIT_V(2); PG8_BAR;
        PG8_STAGE(PG8_SB(1, 0), cB + kstep, voffB); PG8_STAGEA(PG8_SA(1, 0), cA + kstep, voffA); PG8_STAGE(PG8_SB(1, 1), cB + hstepB + kstep, voffB);
        PG8_WAIT_V(6); PG8_BAR;
    } else {
        PG8_STAGE(PG8_SB(0, 0), cB, voffB); PG8_STAGEA(PG8_SA(0, 0), cA, voffA); PG8_STAGE(PG8_SB(0, 1), cB + hstepB, voffB); PG8_STAGEA(PG8_SA(0, 1), cA + hstepA, voffA);
        if (wr == 1) PG8_BAR;
        PG8_WAIT_V(4); PG8_BAR;
        PG8_STAGE(PG8_SB(1, 0), cB + kstep, voffB); PG8_STAGEA(PG8_SA(1, 0), cA + kstep, voffA); PG8_STAGE(PG8_SB(1, 1), cB + hstepB + kstep, voffB);
        PG8_WAIT_V(6); PG8_BAR;
    }
    for (;;) {
        const bool has_next = S.next(ui + 1, nxt);
        const char* nA = has_next ? S.a_base(g, nxt) : cA; const char* nB = has_next ? S.b_base(g, nxt) : cB;
        for (int t = 0; t < nt; t += 2) {
            const bool last = (t == nt - 2);
            const char* a1 = cA + (size_t)(t + 1) * kstep;
            const char* a2 = last ? nA : cA + (size_t)(t + 2) * kstep; const char* b2 = last ? nB : cB + (size_t)(t + 2) * kstep;
            const char* a3 = a2 + kstep; const char* b3 = b2 + kstep;
            if (last && has_next) S.a_ready(nxt);
            if constexpr (SP2) {
            PG8_LDB(B0, 0, 0); PG8_LDB(B1, 0, 1); PG8_SCHED; PG8_LDA(At, 0, 0); PG8_STAGEA(PG8_SA(1, 1), a1 + hstepA, voffA);
            PG8_WAIT_V(8); PG8_WAIT_L(0); PG8_BAR; PG8_MMA(0, 0, At, B0); PG8_MMA(0, 1, At, B1); PG8_BAR; PG8_SCHED;
            PG8_LDA(At, 0, 1); PG8_STAGE(PG8_SB(0, 0), b2, voffB); PG8_STAGE(PG8_SB(0, 1), b2 + hstepB, voffB); PG8_STAGEA(PG8_SA(0, 0), a2, voffA);
            PG8_WAIT_V(8); PG8_WAIT_L(0); PG8_BAR; PG8_MMA(1, 0, At, B0); PG8_MMA(1, 1, At, B1); PG8_BAR; PG8_SCHED;
            PG8_LDB(B0, 1, 0); PG8_LDB(B1, 1, 1); PG8_SCHED; PG8_LDA(At, 1, 0); PG8_STAGEA(PG8_SA(0, 1), a2 + hstepA, voffA);
            PG8_WAIT_V(8); PG8_WAIT_L(0); PG8_BAR; PG8_MMA(0, 0, At, B0); PG8_MMA(0, 1, At, B1); PG8_BAR; PG8_SCHED;
            PG8_LDA(At, 1, 1); PG8_STAGE(PG8_SB(1, 0), b3, voffB); PG8_STAGE(PG8_SB(1, 1), b3 + hstepB, voffB); PG8_STAGEA(PG8_SA(1, 0), a3, voffA);
            PG8_WAIT_V(8); PG8_WAIT_L(0); PG8_BAR; PG8_MMA(1, 0, At, B0); PG8_MMA(1, 1, At, B1); PG8_BAR; PG8_SCHED;
            } else {
            PG8_LDB(B0, 0, 0); PG8_SCHED; PG8_LDA(At, 0, 0); PG8_STAGEA(PG8_SA(1, 1), a1 + hstepA, voffA);
            PG8_WAIT_L(8); PG8_BAR; PG8_WAIT_L(0); PG8_MMA(0, 0, At, B0); PG8_BAR; PG8_SCHED;
            PG8_LDB(B1, 0, 1); PG8_STAGE(PG8_SB(0, 0), b2, voffB);
            PG8_BAR; PG8_WAIT_L(0); PG8_MMA(0, 1, At, B1); PG8_BAR;
            PG8_LDA(At, 0, 1); PG8_STAGEA(PG8_SA(0, 0), a2, voffA);
            PG8_BAR; PG8_WAIT_L(0); PG8_MMA(1, 0, At, B0); PG8_BAR; PG8_SCHED;
            PG8_STAGE(PG8_SB(0, 1), b2 + hstepB, voffB);
            PG8_WAIT_V(6); PG8_BAR; PG8_MMA(1, 1, At, B1); PG8_BAR;
            PG8_LDB(B0, 1, 0); PG8_SCHED; PG8_LDA(At, 1, 0); PG8_STAGEA(PG8_SA(0, 1), a2 + hstepA, voffA);
            PG8_WAIT_L(8); PG8_BAR; PG8_WAIT_L(0); PG8_MMA(0, 0, At, B0); PG8_BAR; PG8_SCHED;
            PG8_LDB(B1, 1, 1); PG8_STAGE(PG8_SB(1, 0), b3, voffB);
            PG8_BAR; PG8_WAIT_L(0); PG8_MMA(0, 1, At, B1); PG8_BAR;
            PG8_LDA(At, 1, 1); PG8_STAGEA(PG8_SA(1, 0), a3, voffA);
            PG8_BAR; PG8_WAIT_L(0); PG8_MMA(1, 0, At, B0); PG8_BAR; PG8_SCHED;
            PG8_STAGE(PG8_SB(1, 1), b3 + hstepB, voffB);
            PG8_WAIT_V(6); PG8_BAR; PG8_MMA(1, 1, At, B1); PG8_BAR;
            }
        }
        if constexpr (ALIGN_EPI) { if (wr == 0) PG8_BAR; }
        if constexpr (!Epi::AFTER_DRAIN) { E(acc, cur, wr, wc, fr, fq); S.done(cur); }
        if (!has_next) break;
#pragma unroll
        for (int a = 0; a < 2; ++a)
#pragma unroll
            for (int b = 0; b < 2; ++b)
#pragma unroll
                for (int m = 0; m < 4; ++m)
#pragma unroll
                    for (int n = 0; n < 2; ++n) acc[a][b][m][n] = (f32x4){0.f, 0.f, 0.f, 0.f};
        cur = nxt; cA = nA; cB = nB; ++ui;
        if constexpr (ALIGN_EPI) { if (wr == 1) PG8_BAR; }
    }
    PG8_WAIT_V(0);
    if constexpr (!ALIGN_EPI) { if (wr == 0) PG8_BAR; }
    PG8_BAR;
    if constexpr (Epi::AFTER_DRAIN) { E.fused(acc, cur, wr, wc, fr, fq, lds, wid, lane); S.done(cur); }
#undef PG8_SA
#undef PG8_SB
#undef PG8_STAGE
#undef PG8_STAGEA
#undef PG8_STAGE_X
#undef PG8_LDA
#undef PG8_LDB
#undef PG8_MMA
#undef PG8_WAIT_V
#undef PG8_WAIT_L
#undef PG8_BAR
#undef PG8_SCHED
}
}
namespace pg8 {
#define EPI_FOR_ROWS _Pragma("unroll") for (int ai = 0; ai < 2; ++ai) _Pragma("unroll") for (int m = 0; m < 4; ++m)
#define EPI_ROW (u.pm * BM + ai * HALF + wr * 64 + m * 16 + fr)
#define EPI_PK8(v0, v1) ((u32x4){cvt_pk_bf16((v0)[0], (v0)[1]), cvt_pk_bf16((v0)[2], (v0)[3]), cvt_pk_bf16((v1)[0], (v1)[1]), cvt_pk_bf16((v1)[2], (v1)[3])})

struct Epi1 {
    static constexpr bool PERM = true, AFTER_DRAIN = false;
    unsigned char* ws; const float* LB;
    __device__ __forceinline__ void operator()(const f32x4 (&acc)[2][2][4][2], const Unit& u, int wr, int wc, int fr, int fq) const {
        const int kind = u.pn >> 2, colt = (u.pn & 3) * BM + wc * 32 + 8 * fq;
        if (kind == 1) {
            f32x4 lb0[2], lb1[2];
#pragma unroll
            for (int bj = 0; bj < 2; ++bj) {
                const f32x4 a0 = *(const f32x4*)(LB + colt + bj * HALF), a1 = *(const f32x4*)(LB + colt + bj * HALF + 4), c0 = *(const f32x4*)(LB + WA + colt + bj * HALF), c1 = *(const f32x4*)(LB + WA + colt + bj * HALF + 4);
#pragma unroll
                for (int j = 0; j < 4; ++j) { const float e0 = __expf(a0[j]), f0 = __expf(c0[j]), e1 = __expf(a1[j]), f1 = __expf(c1[j]); lb0[bj][j] = e0 / (e0 + f0); lb1[bj][j] = e1 / (e1 + f1); } }
            EPI_FOR_ROWS { const int row = EPI_ROW;
#pragma unroll
                for (int bj = 0; bj < 2; ++bj) { f32x4 v0 = acc[ai][bj][m][0], v1 = acc[ai][bj][m][1];
#pragma unroll
                    for (int j = 0; j < 4; ++j) { v0[j] = __logf(lb0[bj][j] + (1.f - lb0[bj][j]) * sigm_f(v0[j])); v1[j] = __logf(lb1[bj][j] + (1.f - lb1[bj][j]) * sigm_f(v1[j])); }
                    float* p = (float*)(ws + WS_LF) + (size_t)row * WA + colt + bj * HALF; *(f32x4*)p = v0; *(f32x4*)(p + 4) = v1; } }
        } else if (kind == 4) {
            EPI_FOR_ROWS { const int row = EPI_ROW;
#pragma unroll
                for (int bj = 0; bj < 2; ++bj) { const int col = colt + bj * HALF; const u32x4 w = EPI_PK8(acc[ai][bj][m][0], acc[ai][bj][m][1]);
                    if (row < NPROMPT) *(u32x4*)((bf16_t*)(ws + WS_UG) + ((size_t)((col >> 4) * 256 + (row >> 5)) * 640 + (row & 31) * 16 + (col & 15))) = w;
                    else *(u32x4*)((bf16_t*)(ws + WS_US) + (size_t)(row - NPROMPT) * WA + col) = w; } }
        } else {
            const size_t ooff = kind == 0 ? WS_QB : (kind == 2 ? WS_VB : WS_GB); bf16_t* O = (bf16_t*)(ws + ooff);
            EPI_FOR_ROWS { const int row = EPI_ROW;
#pragma unroll
                for (int bj = 0; bj < 2; ++bj) { f32x4 v0 = acc[ai][bj][m][0], v1 = acc[ai][bj][m][1];
                    if (kind != 2) {
#pragma unroll
                        for (int j = 0; j < 4; ++j) { v0[j] = silu_f(v0[j]); v1[j] = silu_f(v1[j]); } }
                    *(u32x4*)(O + (size_t)row * WA + colt + bj * HALF) = EPI_PK8(v0, v1); } }
        }
    }
};
struct EpiS1 {
    static constexpr bool PERM = false, AFTER_DRAIN = false;
    float* XLOC;
    __device__ __forceinline__ void operator()(const f32x4 (&acc)[2][2][4][2], const Unit& u, int wr, int wc, int fr, int fq) const {
        EPI_FOR_ROWS { const int row = EPI_ROW;
#pragma unroll
            for (int n = 0; n < 2; ++n) *(f32x4*)(XLOC + ((size_t)u.z * 256 + row) * 128 + wc * 32 + n * 16 + 4 * fq) = acc[ai][0][m][n]; }
    }
};
struct EpiS2 {
    static constexpr bool PERM = true, AFTER_DRAIN = false;
    bf16_t* YBUF;
    __device__ __forceinline__ void operator()(const f32x4 (&acc)[2][2][4][2], const Unit& u, int wr, int wc, int fr, int fq) const {
        EPI_FOR_ROWS { const int row = EPI_ROW;
#pragma unroll
            for (int bj = 0; bj < 2; ++bj) { const int n8 = u.pn * BM + bj * HALF + wc * 32 + 8 * fq; f32x4 v0 = acc[ai][bj][m][0], v1 = acc[ai][bj][m][1];
#pragma unroll
                for (int j = 0; j < 4; ++j) { v0[j] = gelu_tanh_f(v0[j]); v1[j] = gelu_tanh_f(v1[j]); }
                *(u32x4*)(YBUF + ((size_t)row * 32 + (n8 >> 4)) * WA + u.z * 16 + (n8 & 15)) = EPI_PK8(v0, v1); } }
    }
};
struct EpiGlu {
    static constexpr bool PERM = true, AFTER_DRAIN = false;
    const bf16_t* YBUF; const float* gb; bf16_t* MIX;
    __device__ __forceinline__ void operator()(const f32x4 (&acc)[2][2][4][2], const Unit& u, int wr, int wc, int fr, int fq) const {
        const int colt = u.pn * BM + wc * 32 + 8 * fq;
        const __amdgpu_buffer_rsrc_t mr = __builtin_amdgcn_make_buffer_rsrc(MIX, 0, NTOK * DM * 2, 0x00020000);
        f32x4 b0[2], b1[2];
#pragma unroll
        for (int bj = 0; bj < 2; ++bj) { b0[bj] = *(const f32x4*)(gb + colt + bj * HALF); b1[bj] = *(const f32x4*)(gb + colt + bj * HALF + 4); }
        EPI_FOR_ROWS { const int row = EPI_ROW;
#pragma unroll
            for (int bj = 0; bj < 2; ++bj) { const int col = colt + bj * HALF; const u32x4 yw = *(const u32x4*)(YBUF + (size_t)row * WA + col);
                const f32x4 z0 = acc[ai][bj][m][0] + b0[bj], z1 = acc[ai][bj][m][1] + b1[bj]; f32x4 v0, v1;
                v0[0] = bf_lo(yw[0]) * sigm_f(z0[0]); v0[1] = bf_hi(yw[0]) * sigm_f(z0[1]); v0[2] = bf_lo(yw[1]) * sigm_f(z0[2]); v0[3] = bf_hi(yw[1]) * sigm_f(z0[3]);
                v1[0] = bf_lo(yw[2]) * sigm_f(z1[0]); v1[1] = bf_hi(yw[2]) * sigm_f(z1[1]); v1[2] = bf_lo(yw[3]) * sigm_f(z1[2]); v1[3] = bf_hi(yw[3]) * sigm_f(z1[3]);
                __builtin_amdgcn_raw_buffer_store_b128(EPI_PK8(v0, v1), mr, (unsigned)(((size_t)row * DM + WA + col) * 2), 0, 16); } }
    }
};
struct EpiOut {
    static constexpr bool PERM = true, AFTER_DRAIN = false;
    const float *xp, *xs; float* X1; bf16_t* A2; float* SS2;
    __device__ __forceinline__ void operator()(const f32x4 (&acc)[2][2][4][2], const Unit& u, int wr, int wc, int fr, int fq) const {
        const int colt = u.pn * BM + wc * 32 + 8 * fq;
        const __amdgpu_buffer_rsrc_t rs = __builtin_amdgcn_make_buffer_rsrc(A2, 0, NTOK * DM * 2, 0x00020000), xr1 = __builtin_amdgcn_make_buffer_rsrc(X1, 0, NTOK * DM * 4, 0x00020000);
        EPI_FOR_ROWS { const int row = EPI_ROW;
            const float* xr = row < NPROMPT ? xp + (size_t)row * DM : xs + (size_t)(row - NPROMPT) * DM; float ss = 0.f;
#pragma unroll
            for (int bj = 0; bj < 2; ++bj) { const int col = colt + bj * HALF; const f32x4 v0 = acc[ai][bj][m][0] + __builtin_nontemporal_load((const f32x4*)(xr + col)), v1 = acc[ai][bj][m][1] + __builtin_nontemporal_load((const f32x4*)(xr + col + 4));
                __builtin_amdgcn_raw_buffer_store_b128(__builtin_bit_cast(u32x4, v0), xr1, (unsigned)(((size_t)row * DM + col) * 4), 0, 16); __builtin_amdgcn_raw_buffer_store_b128(__builtin_bit_cast(u32x4, v1), xr1, (unsigned)(((size_t)row * DM + col + 4) * 4), 0, 16);
                __builtin_amdgcn_raw_buffer_store_b128(EPI_PK8(v0, v1), rs, (unsigned)(((size_t)row * DM + col) * 2), 0, 16);
                ss += (v0[0] * v0[0] + v0[1] * v0[1]) + (v0[2] * v0[2] + v0[3] * v0[3]) + (v1[0] * v1[0] + v1[1] * v1[1]) + (v1[2] * v1[2] + v1[3] * v1[3]); }
            ss += __shfl_xor(ss, 16); ss += __shfl_xor(ss, 32);
            if (fq == 0) __hip_atomic_fetch_add(SS2 + row, ss, __ATOMIC_RELAXED, __HIP_MEMORY_SCOPE_AGENT); }
    }
};
struct EpiUp {
    static constexpr bool PERM = true, AFTER_DRAIN = false;
    const float* SS2; bf16_t* H;
    __device__ __forceinline__ void operator()(const f32x4 (&acc)[2][2][4][2], const Unit& u, int wr, int wc, int fr, int fq) const {
        const int colt = u.pn * BM + wc * 32 + 8 * fq;
        const __amdgpu_buffer_rsrc_t hr = __builtin_amdgcn_make_buffer_rsrc(H, 0, (unsigned)((size_t)NTOK * DFF * 2), 0x00020000);
        EPI_FOR_ROWS { const int row = EPI_ROW;
            const float rs = rsqrtf(SS2[row] * (1.f / DM) + 1e-6f);
#pragma unroll
            for (int bj = 0; bj < 2; ++bj) { f32x4 v0 = acc[ai][bj][m][0] * rs, v1 = acc[ai][bj][m][1] * rs;
#pragma unroll
                for (int j = 0; j < 4; ++j) { const float a = fmaxf(v0[j], 0.f), b = fmaxf(v1[j], 0.f); v0[j] = a * a; v1[j] = b * b; }
                __builtin_amdgcn_raw_buffer_store_b128(EPI_PK8(v0, v1), hr, (unsigned)(((size_t)row * DFF + colt + bj * HALF) * 2), 0, 16); } }
    }
};
struct EpiDown {
    static constexpr bool PERM = true, AFTER_DRAIN = false;
    unsigned char* ws;
    __device__ __forceinline__ void operator()(const f32x4 (&acc)[2][2][4][2], const Unit& u, int wr, int wc, int fr, int fq) const {
        const int colt = u.pn * BM + wc * 32 + 8 * fq;
        const __amdgpu_buffer_rsrc_t pr = __builtin_amdgcn_make_buffer_rsrc(ws, 0, (unsigned)WS_END, 0x00020000);
        EPI_FOR_ROWS { const int row = EPI_ROW; const unsigned ro = (unsigned)part_off(u.z, row);
#pragma unroll
            for (int bj = 0; bj < 2; ++bj) __builtin_amdgcn_raw_buffer_store_b128(EPI_PK8(acc[ai][bj][m][0], acc[ai][bj][m][1]), pr, ro + (unsigned)((colt + bj * HALF) * 2), 0, 16); }
    }
};
}
constexpr int TR_WAVE_LDS = 64 * 65 * 4;
template <bool WT_SC1 = false, bool NMAJOR = false>
__device__ __forceinline__ void transpose_item(const float* W, int K, int N, bf16_t* WT, LAS float* scr, int item, int lane, const float* kscale) {
    const int nblk = N / 64, kblk = K / 64, kb = NMAJOR ? item % kblk : item / nblk, nb = NMAJOR ? item / kblk : item % nblk, k0 = 64 * kb, n0 = 64 * nb, kr = lane >> 4, n4 = (lane & 15) * 4;
    f32x4 v[16];
#pragma unroll
    for (int i = 0; i < 16; ++i) v[i] = __builtin_nontemporal_load((const f32x4*)(W + (size_t)(k0 + 4 * i + kr) * N + n0 + n4));
#pragma unroll
    for (int i = 0; i < 16; ++i) { const int k = 4 * i + kr; f32x4 x = v[i]; if (kscale) x = x * kscale[k0 + k]; LAS float* d = scr + k * 65 + n4; d[0] = x[0]; d[1] = x[1]; d[2] = x[2]; d[3] = x[3]; }
    LDS_WAIT();
    const int c = lane & 7;
#pragma unroll
    for (int j = 0; j < 8; ++j) { const int n = (lane >> 3) + 8 * j; const LAS float* s = scr + (8 * c) * 65 + n;
        u32x4 o; o.x = cvt_pk_bf16(s[0 * 65], s[1 * 65]); o.y = cvt_pk_bf16(s[2 * 65], s[3 * 65]); o.z = cvt_pk_bf16(s[4 * 65], s[5 * 65]); o.w = cvt_pk_bf16(s[6 * 65], s[7 * 65]);
        if (WT_SC1) { const __amdgpu_buffer_rsrc_t wr = __builtin_amdgcn_make_buffer_rsrc(WT, 0, (unsigned)((size_t)N * K * 2), 0x00020000); __builtin_amdgcn_raw_buffer_store_b128(o, wr, (unsigned)(((size_t)(n0 + n) * K + k0 + 8 * c) * 2), 0, 16); }
        else *(u32x4*)(WT + (size_t)(n0 + n) * K + k0 + 8 * c) = o; }
    LDS_WAIT();
}
__device__ __forceinline__ void rms_row_bf16(const float* xrow, const float* g, bf16_t* orow, int lane) {
    const f32x4* xr = (const f32x4*)xrow + lane; f32x4 v[8]; float s = 0.f;
#pragma unroll
    for (int j = 0; j < 8; ++j) { v[j] = __builtin_nontemporal_load(xr + 64 * j); s += (v[j][0] * v[j][0] + v[j][1] * v[j][1]) + (v[j][2] * v[j][2] + v[j][3] * v[j][3]); }
    const float rstd = rsqrtf(wave_sum(s) * (1.f / DM) + 1e-6f);
    const f32x4* gr = (const f32x4*)g + lane; u32x2* o8 = (u32x2*)orow + lane;
#pragma unroll
    for (int j = 0; j < 8; ++j) { const f32x4 gv = gr[64 * j]; const unsigned long long w = (unsigned long long)cvt_pk_bf16(v[j][0] * rstd * gv[0], v[j][1] * rstd * gv[1]) | ((unsigned long long)cvt_pk_bf16(v[j][2] * rstd * gv[2], v[j][3] * rstd * gv[3]) << 32);
        __hip_atomic_store((unsigned long long*)(o8 + 64 * j), w, __ATOMIC_RELAXED, __HIP_MEMORY_SCOPE_AGENT); }
}

__device__ __forceinline__ void s5_table_item(int g, int q, const float* a_re, const float* a_im, const float* b_re, const float* b_im, const float* c_re, const float* c_im, const float* dd, const float* log_step,
                                              bf16_t* TB, bf16_t* GT, float* LAMT, float* BBT, LAS float* L, int tid) {
    LAS float* LAMR = L; LAS float* LAMI = L + 2112; LAS float* BBR = L + 4224; LAS float* BBI = L + 5248; LAS float* CR = L + 6272; LAS float* CI = L + 7296; LAS float* KQ = L + 8320;
    const float dt = __expf(log_step[g]);
    for (int idx = tid; idx < 2112; idx += 512) { const int j = idx >> 6, p = idx & 63; const float are = a_re[g * 64 + p], aim = a_im[g * 64 + p];
        const float mag = __expf((float)j * are * dt); const float rev = (float)j * (aim * dt) * 0.15915494309189535f; const float fr = rev - rintf(rev);
        LAMR[idx] = mag * cosf(fr * 6.283185307179586f); LAMI[idx] = mag * sinf(fr * 6.283185307179586f); }
    for (int idx = tid; idx < 1024; idx += 512) { const int p = idx >> 4; const float are = a_re[g * 64 + p], aim = a_im[g * 64 + p];
        const float mag = __expf(are * dt); const float rev = (aim * dt) * 0.15915494309189535f; const float fr = rev - rintf(rev);
        const float lr = mag * cosf(fr * 6.283185307179586f), li = mag * sinf(fr * 6.283185307179586f);
        const float den = are * are + aim * aim, nr = lr - 1.f, ni = li, rr = (nr * are + ni * aim) / den, ri = (ni * are - nr * aim) / den;
        const float br = b_re[g * 1024 + idx], bi = b_im[g * 1024 + idx]; BBR[idx] = rr * br - ri * bi; BBI[idx] = rr * bi + ri * br;
        CR[idx] = c_re[g * 1024 + idx]; CI[idx] = c_im[g * 1024 + idx]; }
    __syncthreads();
    {
        const int cc = tid & 255, jh = tid >> 8, c = cc >> 4, c1 = cc & 15; float a4[4] = {0.f, 0.f, 0.f, 0.f};
        for (int p = 0; p < 64; ++p) { const float cr = CR[c * 64 + p], ci = CI[c * 64 + p], br = BBR[p * 16 + c1], bi = BBI[p * 16 + c1]; const float cbr = cr * br - ci * bi, cbi = cr * bi + ci * br;
#pragma unroll
            for (int e = 0; e < 4; ++e) { const int j = 8 * q + 4 * jh + e; a4[e] += LAMR[j * 64 + p] * cbr - LAMI[j * 64 + p] * cbi; } }
#pragma unroll
        for (int e = 0; e < 4; ++e) { const int j = 8 * q + 4 * jh + e; KQ[(4 * jh + e) * 256 + cc] = a4[e] + ((j == 0 && c == c1) ? dd[g * 16 + c] : 0.f); }
    }
    __syncthreads();
    bf16_t* TBg = TB + (size_t)g * 512 * 640;
    for (int idx = tid; idx < 4096; idx += 512) {
        const int jl = idx >> 9, t = (idx >> 4) & 31, c = idx & 15, j = 8 * q + jl;
        if (t >= j) { const LAS float* k = KQ + jl * 256 + c * 16; u32x4 w0, w1;
            w0.x = cvt_pk_bf16(k[0], k[1]); w0.y = cvt_pk_bf16(k[2], k[3]); w0.z = cvt_pk_bf16(k[4], k[5]); w0.w = cvt_pk_bf16(k[6], k[7]);
            w1.x = cvt_pk_bf16(k[8], k[9]); w1.y = cvt_pk_bf16(k[10], k[11]); w1.z = cvt_pk_bf16(k[12], k[13]); w1.w = cvt_pk_bf16(k[14], k[15]);
            u32x4* d = (u32x4*)(TBg + (size_t)(t * 16 + c) * 640 + (t - j) * 16); d[0] = w0; d[1] = w1; } }
    for (int idx = tid; idx < 4096; idx += 512) {
        const int tl = idx >> 9, c = (idx >> 5) & 15, s = idx & 31, t = 8 * q + tl;
        if (s > t) { u32x4* d = (u32x4*)(TBg + (size_t)(t * 16 + c) * 640 + s * 16); d[0] = (u32x4){0u, 0u, 0u, 0u}; d[1] = (u32x4){0u, 0u, 0u, 0u}; } }
    for (int idx = tid; idx < 16384; idx += 512) {
        const int p = idx & 63, ri = (idx >> 6) & 1, c = (idx >> 7) & 15, tl = idx >> 11, t = 8 * q + tl;
        const float lr = LAMR[(t + 1) * 64 + p], li = LAMI[(t + 1) * 64 + p], cr = CR[c * 64 + p], ci = CI[c * 64 + p];
        const float val = ri == 0 ? (cr * lr - ci * li) : -(cr * li + ci * lr);
        TBg[(size_t)(t * 16 + c) * 640 + 512 + ri * 64 + p] = f2bf(val); }
    bf16_t* GTg = GT + (size_t)g * 256 * 512;
    for (int idx = tid; idx < 16384; idx += 512) {
        const int sc = idx & 511, s = sc >> 4, c1 = sc & 15, r = 32 * q + (idx >> 9), ri = r >> 6, p = r & 63;
        const float lr = LAMR[(31 - s) * 64 + p], li = LAMI[(31 - s) * 64 + p], br = BBR[p * 16 + c1], bi = BBI[p * 16 + c1];
        GTg[(size_t)r * 512 + sc] = f2bf(ri == 0 ? (lr * br - li * bi) : (lr * bi + li * br)); }
    for (int idx = tid; idx < 2048; idx += 512) {
        ((u32x4*)(GTg + (size_t)(128 + 32 * q) * 512))[idx] = (u32x4){0u, 0u, 0u, 0u}; }
    if (q == 0) {
        if (tid < 64) { f32x4 v; v[0] = LAMR[64 + tid]; v[1] = LAMI[64 + tid]; v[2] = LAMR[32 * 64 + tid]; v[3] = LAMI[32 * 64 + tid]; *(f32x4*)(LAMT + (size_t)(g * 64 + tid) * 4) = v; }
        for (int idx = tid; idx < 1024; idx += 512) { const int p = idx >> 4, c1 = idx & 15; *(f32x2*)(BBT + ((size_t)(g * 8 + (c1 >> 1)) * 64 + p) * 4 + (c1 & 1) * 2) = (f32x2){BBR[idx], BBI[idx]}; }
    }
    __syncthreads();
}

__device__ __forceinline__ void hgrn_pre_load(int item, const float* LF, const bf16_t* QB, const bf16_t* VB, float (&lf)[16], bf16_t (&qv)[16], bf16_t (&vv)[16], int tid) {
    const int bh = item >> 5, c = item & 31, b = bh >> 3, h = bh & 7, seg = tid >> 7, k = tid & 127;
    const size_t base = (size_t)(b * 2048 + c * 64 + seg * 16) * WA + h * 128 + k;
#pragma unroll
    for (int i = 0; i < 16; ++i) { lf[i] = __builtin_nontemporal_load(LF + base + (size_t)i * WA); qv[i] = __builtin_nontemporal_load(QB + base + (size_t)i * WA); vv[i] = __builtin_nontemporal_load(VB + base + (size_t)i * WA); }
}
__device__ __forceinline__ void hgrn_pre_compute(int item, const float (&lf)[16], const bf16_t (&qv)[16], const bf16_t (&vv)[16], bf16_t* PRE, float* DL, unsigned* cntp, LAS float* tot, int tid) {
    const int seg = tid >> 7, k = tid & 127;
    float pl[16]; float run = 0.f;
#pragma unroll
    for (int i = 0; i < 16; ++i) { run += lf[i]; pl[i] = run; }
    tot[seg * 128 + k] = run;
    BAR_LDS();
    float off = 0.f, bl = 0.f;
#pragma unroll
    for (int s = 0; s < 4; ++s) { const float t = tot[s * 128 + k]; if (s < seg) off += t; bl += t; }
    BAR_LDS();
    const __amdgpu_buffer_rsrc_t pr = __builtin_amdgcn_make_buffer_rsrc(PRE, 0, 64 * 1048576, 0x00020000); const unsigned pb = (unsigned)item * 65536u;
    float kh[16];
#pragma unroll
    for (int i = 0; i < 16; ++i) { const float bc = pl[i] + off, kk = 1.f - __expf(lf[i]);
        __builtin_amdgcn_raw_buffer_store_b16((short)f2bf(bf2f(qv[i]) * __expf(bc)), pr, pb + (unsigned)(((seg * 16 + i) * 128 + k) * 2), 0, 16);
        __builtin_amdgcn_raw_buffer_store_b16((short)f2bf(kk * __expf(-bc)), pr, pb + (unsigned)((8192 + (seg * 16 + i) * 128 + k) * 2), 0, 16); kh[i] = kk * __expf(bl - bc); }
    u32x4 w0, w1;
    w0.x = cvt_pk_bf16(kh[0], kh[1]); w0.y = cvt_pk_bf16(kh[2], kh[3]); w0.z = cvt_pk_bf16(kh[4], kh[5]); w0.w = cvt_pk_bf16(kh[6], kh[7]);
    w1.x = cvt_pk_bf16(kh[8], kh[9]); w1.y = cvt_pk_bf16(kh[10], kh[11]); w1.z = cvt_pk_bf16(kh[12], kh[13]); w1.w = cvt_pk_bf16(kh[14], kh[15]);
    __builtin_amdgcn_raw_buffer_store_b128(w0, pr, pb + (unsigned)((16384 + k * 64 + seg * 16) * 2), 0, 16); __builtin_amdgcn_raw_buffer_store_b128(w1, pr, pb + (unsigned)((16384 + k * 64 + seg * 16) * 2 + 16), 0, 16);
    w0.x = (unsigned)vv[0] | ((unsigned)vv[1] << 16); w0.y = (unsigned)vv[2] | ((unsigned)vv[3] << 16); w0.z = (unsigned)vv[4] | ((unsigned)vv[5] << 16); w0.w = (unsigned)vv[6] | ((unsigned)vv[7] << 16);
    w1.x = (unsigned)vv[8] | ((unsigned)vv[9] << 16); w1.y = (unsigned)vv[10] | ((unsigned)vv[11] << 16); w1.z = (unsigned)vv[12] | ((unsigned)vv[13] << 16); w1.w = (unsigned)vv[14] | ((unsigned)vv[15] << 16);
    __builtin_amdgcn_raw_buffer_store_b128(w0, pr, pb + (unsigned)((24576 + k * 64 + seg * 16) * 2), 0, 16); __builtin_amdgcn_raw_buffer_store_b128(w1, pr, pb + (unsigned)((24576 + k * 64 + seg * 16) * 2 + 16), 0, 16);
    if (seg == 0) __hip_atomic_store(DL + (size_t)item * 128 + k, __expf(bl), __ATOMIC_RELAXED, __HIP_MEMORY_SCOPE_AGENT);
    asm volatile("s_waitcnt vmcnt(0)" ::: "memory");
    if ((tid & 63) == 0) __hip_atomic_fetch_add(cntp + 16 * (item >> 3), 1u, __ATOMIC_RELAXED, __HIP_MEMORY_SCOPE_AGENT);
}

constexpr int CH_QT = 0, CH_KT = 17408, CH_KH = 34816, CH_VT = 53248, CH_P = 71680, CH_ST = 80896, CH_DL = 115712;
__device__ __forceinline__ bf16x8 ldfrag(const LAS unsigned char* base, int row, int stride, int kb) { return *(const LAS bf16x8*)(base + row * stride + kb); }
__device__ __forceinline__ void hgrn_chain(int b, int h, int seg, const bf16_t* PRE, const float* DL, float* ORAW, float* SLOC, float* DSEG, const unsigned* cntp, LAS unsigned char* lds, int tid) {
    const int lane = tid & 63, w = __builtin_amdgcn_readfirstlane(tid >> 6), l15 = lane & 15, lq = lane >> 4;
    f32x4 sacc[8];
#pragma unroll
    for (int i = 0; i < 8; ++i) sacc[i] = (f32x4){0.f, 0.f, 0.f, 0.f};
    for (int i = tid; i < 34816 / 16; i += 512) ((LAS u32x4*)(lds + CH_ST))[i] = (u32x4){0u, 0u, 0u, 0u};
    const int item0 = (b * 8 + h) * 32 + seg * 8, chunk0 = seg * 8;
    if (tid == 0) { const unsigned* wp = cntp + 16 * ((b * 8 + h) * 4 + seg); while (__hip_atomic_load(wp, __ATOMIC_RELAXED, __HIP_MEMORY_SCOPE_AGENT) < 64u) __builtin_amdgcn_s_sleep(4);
        __builtin_amdgcn_fence(__ATOMIC_ACQUIRE, "agent"); asm volatile("s_waitcnt vmcnt(0)" ::: "memory"); }
    __syncthreads();
    u32x4 pfA[8], pfB[8]; float dlA = 0.f, dlB = 0.f, dprod = 1.f;
#define CH_LOAD(PF, DLV, cc) do { const u32x4* src_ = (const u32x4*)(PRE + (size_t)(item0 + (cc)) * 32768); _Pragma("unroll") for (int j = 0; j < 8; ++j) PF[j] = src_[tid + 512 * j]; \
        if (tid < 128) DLV = DL[(size_t)(item0 + (cc)) * 128 + tid]; } while (0)
#define CH_STEP(PF, DLV, c) do { \
        _Pragma("unroll") for (int j = 0; j < 8; ++j) { const int pi = (tid + 512 * j) & 1023; int off; \
            if (j < 2) off = CH_QT + (pi >> 4) * 272 + (pi & 15) * 16; else if (j < 4) off = CH_KT + (pi >> 4) * 272 + (pi & 15) * 16; \
            else if (j < 6) off = CH_KH + (pi >> 3) * 144 + (pi & 7) * 16; else off = CH_VT + (pi >> 3) * 144 + (pi & 7) * 16; \
            *(LAS u32x4*)(lds + off) = PF[j]; } \
        if (tid < 128) { ((LAS float*)(lds + CH_DL))[tid] = DLV; dprod *= DLV; } \
        BAR_LDS();                                                                               \
        if ((c) + 2 < 8) CH_LOAD(PF, DLV, (c) + 2);                                               \
        { const int tt = w >> 1; \
          _Pragma("unroll") for (int e = 0; e < 2; ++e) { const int st = (w & 1) * 2 + e; f32x4 a = (f32x4){0.f, 0.f, 0.f, 0.f}; \
            _Pragma("unroll") for (int ks = 0; ks < 4; ++ks) a = __builtin_amdgcn_mfma_f32_16x16x32_bf16(ldfrag(lds + CH_KT, 16 * st + l15, 272, (ks * 32 + 8 * lq) * 2), ldfrag(lds + CH_QT, 16 * tt + l15, 272, (ks * 32 + 8 * lq) * 2), a, 0, 0, 0); \
            const int t = 16 * tt + l15, s0 = 16 * st + 4 * lq; \
            _Pragma("unroll") for (int j = 0; j < 4; ++j) a[j] = (s0 + j <= t) ? a[j] : 0.f; \
            *(LAS u32x2*)(lds + CH_P + t * 144 + s0 * 2) = (u32x2){cvt_pk_bf16(a[0], a[1]), cvt_pk_bf16(a[2], a[3])}; } } \
        BAR_LDS();                                                                               \
        bf16x8 aV[2], aS[4]; \
        _Pragma("unroll") for (int ss = 0; ss < 2; ++ss) aV[ss] = ldfrag(lds + CH_VT, 16 * w + l15, 144, (ss * 32 + 8 * lq) * 2); \
        _Pragma("unroll") for (int ks = 0; ks < 4; ++ks) aS[ks] = ldfrag(lds + CH_ST, 16 * w + l15, 272, (ks * 32 + 8 * lq) * 2); \
        const int tok0 = b * 2048 + (chunk0 + (c)) * 64; \
        _Pragma("unroll") for (int tt = 0; tt < 4; ++tt) { f32x4 a = (f32x4){0.f, 0.f, 0.f, 0.f}; \
            _Pragma("unroll") for (int ss = 0; ss < 2; ++ss) a = __builtin_amdgcn_mfma_f32_16x16x32_bf16(aV[ss], ldfrag(lds + CH_P, 16 * tt + l15, 144, (ss * 32 + 8 * lq) * 2), a, 0, 0, 0); \
            _Pragma("unroll") for (int ks = 0; ks < 4; ++ks) a = __builtin_amdgcn_mfma_f32_16x16x32_bf16(aS[ks], ldfrag(lds + CH_QT, 16 * tt + l15, 272, (ks * 32 + 8 * lq) * 2), a, 0, 0, 0); \
            __builtin_nontemporal_store(a, (f32x4*)(ORAW + (size_t)(tok0 + 16 * tt + l15) * WA + h * 128 + 16 * w + 4 * lq)); } \
        _Pragma("unroll") for (int kt = 0; kt < 8; ++kt) { const f32x4 d4 = *(const LAS f32x4*)(lds + CH_DL + (16 * kt + 4 * lq) * 4); sacc[kt] = sacc[kt] * d4; \
            _Pragma("unroll") for (int ss = 0; ss < 2; ++ss) sacc[kt] = __builtin_amdgcn_mfma_f32_16x16x32_bf16(ldfrag(lds + CH_KH, 16 * kt + l15, 144, (ss * 32 + 8 * lq) * 2), aV[ss], sacc[kt], 0, 0, 0); } \
        BAR_LDS();                                                                               \
        _Pragma("unroll") for (int kt = 0; kt < 8; ++kt) *(LAS u32x2*)(lds + CH_ST + (16 * w + l15) * 272 + (16 * kt + 4 * lq) * 2) = (u32x2){cvt_pk_bf16(sacc[kt][0], sacc[kt][1]), cvt_pk_bf16(sacc[kt][2], sacc[kt][3])}; \
    } while (0)
    CH_LOAD(pfA, dlA, 0); CH_LOAD(pfB, dlB, 1);
    for (int c = 0; c < 8; c += 2) { CH_STEP(pfA, dlA, c); CH_STEP(pfB, dlB, c + 1); }
#undef CH_LOAD
#undef CH_STEP
    {   float* sl = SLOC + (size_t)((b * 8 + h) * 4 + seg) * 16384;
#pragma unroll
        for (int kt = 0; kt < 8; ++kt)
#pragma unroll
            for (int j = 0; j < 1; ++j) ((f32x4*)sl)[(w * 8 + kt) * 64 + lane] = sacc[kt];
        if (tid < 128) DSEG[(size_t)((b * 8 + h) * 4 + seg) * 128 + tid] = dprod; }
    __syncthreads();
}

__device__ __forceinline__ void hgrn_corr(int b, int h, int seg, const bf16_t* PRE, const float* DL, const float* SLOC, const float* DSEG, float* ORAW, float* out_state, unsigned* cdone, LAS unsigned char* lds, int tid) {
    const int lane = tid & 63, w = __builtin_amdgcn_readfirstlane(tid >> 6), l15 = lane & 15, lq = lane >> 4, bh = b * 8 + h;
    f32x4 sacc[8];
#pragma unroll
    for (int i = 0; i < 8; ++i) sacc[i] = (f32x4){0.f, 0.f, 0.f, 0.f};
    for (int sp = 0; sp < seg; ++sp) {
        const float* sl = SLOC + (size_t)(bh * 4 + sp) * 16384; const float* dg = DSEG + (size_t)(bh * 4 + sp) * 128;
#pragma unroll
        for (int kt = 0; kt < 8; ++kt) { const f32x4 d4 = *(const f32x4*)(dg + 16 * kt + 4 * lq);
#pragma unroll
            for (int j = 0; j < 1; ++j) { const f32x4 sv = ((const f32x4*)sl)[(w * 8 + kt) * 64 + lane]; sacc[kt] = sacc[kt] * d4 + sv; } }
    }
    const int item0 = bh * 32 + seg * 8;
    u32x4 q0, q1; float dlv = 0.f;
    { const u32x4* src = (const u32x4*)(PRE + (size_t)item0 * 32768); q0 = src[tid]; q1 = src[tid + 512]; if (tid < 128) dlv = DL[(size_t)item0 * 128 + tid]; }
    f32x4 ov[4];
#pragma unroll
    for (int tt = 0; tt < 4; ++tt) ov[tt] = *(const f32x4*)(ORAW + (size_t)(b * 2048 + seg * 512 + 16 * tt + l15) * WA + h * 128 + 16 * w + 4 * lq);
    for (int c = 0; c < 8; ++c) {
        { const int p0 = tid, p1 = tid + 512; *(LAS u32x4*)(lds + CH_QT + (p0 >> 4) * 272 + (p0 & 15) * 16) = q0; *(LAS u32x4*)(lds + CH_QT + (p1 >> 4) * 272 + (p1 & 15) * 16) = q1;
          if (tid < 128) ((LAS float*)(lds + CH_DL))[tid] = dlv; }
#pragma unroll
        for (int kt = 0; kt < 8; ++kt) *(LAS u32x2*)(lds + CH_ST + (16 * w + l15) * 272 + (16 * kt + 4 * lq) * 2) = (u32x2){cvt_pk_bf16(sacc[kt][0], sacc[kt][1]), cvt_pk_bf16(sacc[kt][2], sacc[kt][3])};
        BAR_LDS();
        if (c + 1 < 8) { const u32x4* src = (const u32x4*)(PRE + (size_t)(item0 + c + 1) * 32768); q0 = src[tid]; q1 = src[tid + 512]; if (tid < 128) dlv = DL[(size_t)(item0 + c + 1) * 128 + tid]; }
        const int tok0 = b * 2048 + (seg * 8 + c) * 64;
        f32x4 ovn[4];
#pragma unroll
        for (int tt = 0; tt < 4; ++tt) ovn[tt] = (c + 1 < 8) ? *(const f32x4*)(ORAW + (size_t)(tok0 + 64 + 16 * tt + l15) * WA + h * 128 + 16 * w + 4 * lq) : (f32x4){0.f, 0.f, 0.f, 0.f};
        bf16x8 aS[4];
#pragma unroll
        for (int ks = 0; ks < 4; ++ks) aS[ks] = ldfrag(lds + CH_ST, 16 * w + l15, 272, (ks * 32 + 8 * lq) * 2);
#pragma unroll
        for (int tt = 0; tt < 4; ++tt) { f32x4 a = ov[tt];
#pragma unroll
            for (int ks = 0; ks < 4; ++ks) a = __builtin_amdgcn_mfma_f32_16x16x32_bf16(aS[ks], ldfrag(lds + CH_QT, 16 * tt + l15, 272, (ks * 32 + 8 * lq) * 2), a, 0, 0, 0);
            *(f32x4*)(ORAW + (size_t)(tok0 + 16 * tt + l15) * WA + h * 128 + 16 * w + 4 * lq) = a; }
#pragma unroll
        for (int kt = 0; kt < 8; ++kt) { const f32x4 d4 = *(const LAS f32x4*)(lds + CH_DL + (16 * kt + 4 * lq) * 4); sacc[kt] = sacc[kt] * d4; }
#pragma unroll
        for (int tt = 0; tt < 4; ++tt) ov[tt] = ovn[tt];
        BAR_LDS();
    }
    if (seg == 3 && out_state) {
        const float* sl = SLOC + (size_t)(bh * 4 + 3) * 16384;
#pragma unroll
        for (int kt = 0; kt < 8; ++kt)
#pragma unroll
            for (int j = 0; j < 4; ++j) out_state[((size_t)bh * 128 + 16 * kt + 4 * lq + j) * 128 + 16 * w + l15] = sacc[kt][j] + ((const f32x4*)sl)[(w * 8 + kt) * 64 + lane][j]; }
    __syncthreads();
    if (tid == 0) { __builtin_amdgcn_fence(__ATOMIC_RELEASE, "agent"); asm volatile("s_waitcnt vmcnt(0)" ::: "memory");
        __hip_atomic_fetch_add(cdone, 8u, __ATOMIC_RELAXED, __HIP_MEMORY_SCOPE_AGENT); }
    __syncthreads();
}

__device__ __forceinline__ void hgrn_sample_load(int bh, const float* LF, const bf16_t* QB, const bf16_t* VB, const float* s0, f32x4 (&S)[8], float& tf, bf16_t& tq, bf16_t& tv, int tid) {
    const int b = bh >> 3, h = bh & 7, v4 = tid & 31, kr = tid >> 5;
    { const int t = tid >> 7, k = tid & 127; const size_t rb = (size_t)(NPROMPT + b * 4 + t) * WA + h * 128 + k; tf = LF[rb]; tq = QB[rb]; tv = VB[rb]; }
#pragma unroll
    for (int i = 0; i < 8; ++i) S[i] = __builtin_nontemporal_load((const f32x4*)(s0 + ((size_t)bh * 128 + kr * 8 + i) * 128 + 4 * v4));
}
__device__ __forceinline__ void hgrn_sample_compute(int bh, f32x4 (&S)[8], float tf, bf16_t tq, bf16_t tv, float* ORAWS, float* out_state, LAS float* L, int tid) {
    const int b = bh >> 3, h = bh & 7, v4 = tid & 31, kr = tid >> 5;
    { const int t = tid >> 7, k = tid & 127; const float f = __expf(tf); L[(t * 3 + 0) * 128 + k] = f; L[(t * 3 + 1) * 128 + k] = 1.f - f; L[(t * 3 + 2) * 128 + k] = bf2f(tq); L[1536 + t * 128 + k] = bf2f(tv); }
    BAR_LDS();
#pragma unroll
    for (int t = 0; t < 4; ++t) {
        const f32x4 vv = *(const LAS f32x4*)(L + 1536 + t * 128 + 4 * v4); f32x4 po = (f32x4){0.f, 0.f, 0.f, 0.f};
        const f32x4 f0 = *(const LAS f32x4*)(L + (t * 3 + 0) * 128 + kr * 8), f1 = *(const LAS f32x4*)(L + (t * 3 + 0) * 128 + kr * 8 + 4), k0 = *(const LAS f32x4*)(L + (t * 3 + 1) * 128 + kr * 8), k1 = *(const LAS f32x4*)(L + (t * 3 + 1) * 128 + kr * 8 + 4),
                    q0 = *(const LAS f32x4*)(L + (t * 3 + 2) * 128 + kr * 8), q1 = *(const LAS f32x4*)(L + (t * 3 + 2) * 128 + kr * 8 + 4);
#pragma unroll
        for (int i = 0; i < 8; ++i) { const float f = i < 4 ? f0[i & 3] : f1[i & 3], kk = i < 4 ? k0[i & 3] : k1[i & 3], q = i < 4 ? q0[i & 3] : q1[i & 3];
            S[i] = S[i] * f + vv * kk; po += S[i] * q; }
        *(LAS f32x4*)(L + 2048 + (t * 16 + kr) * 128 + 4 * v4) = po;
    }
    BAR_LDS();
    { const int t = tid >> 7, v = tid & 127; float s = 0.f;
#pragma unroll
      for (int j = 0; j < 16; ++j) s += L[2048 + (t * 16 + j) * 128 + v];
      ORAWS[(size_t)(b * 4 + t) * WA + h * 128 + v] = s; }
    if (out_state) {
#pragma unroll
    for (int i = 0; i < 8; ++i) __builtin_nontemporal_store(S[i], (f32x4*)(out_state + ((size_t)bh * 128 + kr * 8 + i) * 128 + 4 * v4)); }
    BAR_LDS();
}

__device__ __forceinline__ void s5_scan(int g, const float* XLOC, const float* LAMT, bf16_t* UG, float* o_rp, float* o_ip, unsigned* cnts, int tid) {
    const __amdgpu_buffer_rsrc_t ur = __builtin_amdgcn_make_buffer_rsrc(UG, 0, 20 * 1048576, 0x00020000);
    if (tid < 256) { const int b = tid >> 6, p = tid & 63; const f32x4 lm = *(const f32x4*)(LAMT + (size_t)(g * 64 + p) * 4); const float l32r = lm[2], l32i = lm[3];
        float cr = 0.f, ci = 0.f;
        for (int cb = 0; cb < 4; ++cb) { float xr[16], xi[16];
#pragma unroll
            for (int i = 0; i < 16; ++i) { const size_t row = (size_t)g * 256 + b * 64 + cb * 16 + i; xr[i] = XLOC[row * 128 + p]; xi[i] = XLOC[row * 128 + 64 + p]; }
#pragma unroll
            for (int i = 0; i < 16; ++i) { const size_t row = (size_t)g * 256 + b * 64 + cb * 16 + i;
                __builtin_amdgcn_raw_buffer_store_b16((short)f2bf(cr), ur, (unsigned)((row * 640 + 512 + p) * 2), 0, 16); __builtin_amdgcn_raw_buffer_store_b16((short)f2bf(ci), ur, (unsigned)((row * 640 + 576 + p) * 2), 0, 16);
                const float nr = l32r * cr - l32i * ci + xr[i], ni = l32r * ci + l32i * cr + xi[i]; cr = nr; ci = ni; } }
        if (o_rp) o_rp[(size_t)(b * 64 + g) * 64 + p] = cr; if (o_ip) o_ip[(size_t)(b * 64 + g) * 64 + p] = ci; }
    asm volatile("s_waitcnt vmcnt(0)" ::: "memory");
    __syncthreads();
    if (tid == 0) __hip_atomic_fetch_add(cnts + 16 * g, 1u, __ATOMIC_RELAXED, __HIP_MEMORY_SCOPE_AGENT);
}

__device__ __forceinline__ void s5_sample_item(int item, const bf16_t* US, const float* LAMT, const float* BBT, const float* c_re, const float* c_im, const float* dd, const float* x0r, const float* x0i,
                                               bf16_t* YBUF, float* o_rs, float* o_is, LAS float* L, int tid) {
    const int g = item >> 4, b = (item & 15) * 8 + (tid >> 6), lane = tid & 63, wv = tid >> 6;
    LAS float* CRs = L; LAS float* CIs = L + 16 * 68; LAS float* XS = L + 2 * 16 * 68 + wv * 512;
    for (int idx = tid; idx < 1024; idx += 512) { const int c = idx >> 6, p = idx & 63; CRs[c * 68 + p] = c_re[g * 1024 + idx]; CIs[c * 68 + p] = c_im[g * 1024 + idx]; }
    const f32x4 lm = *(const f32x4*)(LAMT + (size_t)(g * 64 + lane) * 4);
    float xr = x0r[(size_t)(b * 64 + g) * 64 + lane], xi = x0i[(size_t)(b * 64 + g) * 64 + lane];
    float bbr[16], bbi[16];
#pragma unroll
    for (int c = 0; c < 16; c += 2) { const f32x4 v = *(const f32x4*)(BBT + ((size_t)(g * 8 + (c >> 1)) * 64 + lane) * 4); bbr[c] = v[0]; bbi[c] = v[1]; bbr[c + 1] = v[2]; bbi[c + 1] = v[3]; }
    float myu = 0.f;
#pragma unroll
    for (int t = 0; t < 4; ++t) {
        const u32x4* up = (const u32x4*)(US + (size_t)(b * 4 + t) * WA + g * 16); const u32x4 u0 = up[0], u1 = up[1];
        const float u[16] = {bf_lo(u0.x), bf_hi(u0.x), bf_lo(u0.y), bf_hi(u0.y), bf_lo(u0.z), bf_hi(u0.z), bf_lo(u0.w), bf_hi(u0.w), bf_lo(u1.x), bf_hi(u1.x), bf_lo(u1.y), bf_hi(u1.y), bf_lo(u1.z), bf_hi(u1.z), bf_lo(u1.w), bf_hi(u1.w)};
        float br = 0.f, bi = 0.f;
#pragma unroll
        for (int c = 0; c < 16; ++c) { br += bbr[c] * u[c]; bi += bbi[c] * u[c]; if ((lane >> 4) == t && (lane & 15) == c) myu = u[c]; }
        const float nr = lm[0] * xr - lm[1] * xi + br, ni = lm[0] * xi + lm[1] * xr + bi; xr = nr; xi = ni;
        XS[(t * 2 + 0) * 64 + lane] = xr; XS[(t * 2 + 1) * 64 + lane] = xi;
    }
    if (o_rs) o_rs[(size_t)(b * 64 + g) * 64 + lane] = xr; if (o_is) o_is[(size_t)(b * 64 + g) * 64 + lane] = xi;
    BAR_LDS();
    { const int t = lane >> 4, c = lane & 15; float y = 0.f;
#pragma unroll 4
      for (int p = 0; p < 64; p += 4) { const f32x4 cr = *(const LAS f32x4*)(CRs + c * 68 + p), ci = *(const LAS f32x4*)(CIs + c * 68 + p), xr4 = *(const LAS f32x4*)(XS + (t * 2) * 64 + p), xi4 = *(const LAS f32x4*)(XS + (t * 2 + 1) * 64 + p);
          y += (cr[0] * xr4[0] - ci[0] * xi4[0]) + (cr[1] * xr4[1] - ci[1] * xi4[1]) + (cr[2] * xr4[2] - ci[2] * xi4[2]) + (cr[3] * xr4[3] - ci[3] * xi4[3]); }
      y += dd[g * 16 + c] * myu;
      YBUF[(size_t)(NPROMPT + b * 4 + t) * WA + g * 16 + c] = f2bf(gelu_tanh_f(y)); }
    BAR_LDS();
}

__device__ __forceinline__ void gate_row(int tok, const float* ORAW, const float* ORAWS, const bf16_t* GB, const float* ng, bf16_t* MIX, int lane) {
    const float* orow = tok < NPROMPT ? ORAW + (size_t)tok * WA : ORAWS + (size_t)(tok - NPROMPT) * WA;
    f32x4 v[4]; float s = 0.f;
#pragma unroll
    for (int j = 0; j < 4; ++j) { v[j] = __builtin_nontemporal_load((const f32x4*)orow + lane + 64 * j); s += (v[j][0] * v[j][0] + v[j][1] * v[j][1]) + (v[j][2] * v[j][2] + v[j][3] * v[j][3]); }
    const float rstd = rsqrtf(wave_sum(s) * (1.f / WA) + 1e-6f);
#pragma unroll
    for (int j = 0; j < 4; ++j) { const f32x4 gv = ((const f32x4*)ng)[lane + 64 * j]; const u32x2 gw = ((const u32x2*)(GB + (size_t)tok * WA))[lane + 64 * j];
        const unsigned long long w = (unsigned long long)cvt_pk_bf16(v[j][0] * rstd * gv[0] * bf_lo(gw.x), v[j][1] * rstd * gv[1] * bf_hi(gw.x)) | ((unsigned long long)cvt_pk_bf16(v[j][2] * rstd * gv[2] * bf_lo(gw.y), v[j][3] * rstd * gv[3] * bf_hi(gw.y)) << 32);
        __hip_atomic_store((unsigned long long*)(MIX + (size_t)tok * DM) + lane + 64 * j, w, __ATOMIC_RELAXED, __HIP_MEMORY_SCOPE_AGENT); }
}

__device__ __forceinline__ void final_row(int tok, float* X1, const unsigned char* ws, const float* gf, int lane) {
    f32x4* xr = (f32x4*)(X1 + (size_t)tok * DM); f32x4 v[8]; float s = 0.f;
#pragma unroll
    for (int j = 0; j < 8; ++j) { v[j] = __builtin_nontemporal_load(xr + lane + 64 * j);
#pragma unroll
        for (int z = 0; z < 4; ++z) { const u32x2 pw = __builtin_nontemporal_load((const u32x2*)(ws + part_off(z, tok)) + lane + 64 * j); v[j][0] += bf_lo(pw.x); v[j][1] += bf_hi(pw.x); v[j][2] += bf_lo(pw.y); v[j][3] += bf_hi(pw.y); }
        s += (v[j][0] * v[j][0] + v[j][1] * v[j][1]) + (v[j][2] * v[j][2] + v[j][3] * v[j][3]); }
    const float rstd = rsqrtf(wave_sum(s) * (1.f / DM) + 1e-6f);
#pragma unroll
    for (int j = 0; j < 8; ++j) { const f32x4 gv = ((const f32x4*)gf)[lane + 64 * j]; __builtin_nontemporal_store((f32x4){v[j][0] * rstd * gv[0], v[j][1] * rstd * gv[1], v[j][2] * rstd * gv[2], v[j][3] * rstd * gv[3]}, xr + lane + 64 * j); }
}
constexpr int LDS_BYTES = 147456, NPH = 6;
struct Args { const float* in[24]; float* out; unsigned char* ws; int ph_lo, ph_hi, coop, omask; };

__global__ void __launch_bounds__(512, 2) mk(Args a) {
    extern __shared__ __attribute__((aligned(16))) unsigned char lds_raw[];
    LAS unsigned char* lds = (LAS unsigned char*)lds_raw;
    cg::grid_group grid = cg::this_grid();
    const int tid = threadIdx.x, lane = tid & 63, wave = __builtin_amdgcn_readfirstlane(tid >> 6), G = gridDim.x, blk = blockIdx.x;
    const int gw = blk * 8 + wave, NGW = G * 8;
    unsigned char* ws = a.ws; float* out = a.out;
    const float *x_p = a.in[0], *x_s = a.in[1];
    bf16_t* UG = (bf16_t*)(ws + WS_UG); float* XLOC = (float*)(ws + WS_XLOC); bf16_t* US = (bf16_t*)(ws + WS_US); bf16_t* WTDOWN = (bf16_t*)(ws + WS_WTDOWN);
    bf16_t* HB = (bf16_t*)(ws + WS_HB); bf16_t* YBUF = (bf16_t*)(ws + WS_YBUF); bf16_t* QB = (bf16_t*)(ws + WS_QB); bf16_t* VB = (bf16_t*)(ws + WS_VB); bf16_t* GB = (bf16_t*)(ws + WS_GB);
    float* LF = (float*)(ws + WS_LF); float* ORAW = LF; bf16_t* WTGLU = (bf16_t*)(ws + WS_WTGLU); bf16_t* WTOUT = (bf16_t*)(ws + WS_WTOUT); bf16_t* HH = (bf16_t*)(ws + WS_H);
    bf16_t* WTIN = (bf16_t*)(ws + WS_WTIN); bf16_t* PRE = (bf16_t*)(ws + WS_PRE); bf16_t* WTUP = (bf16_t*)(ws + WS_WTUP); bf16_t* A2 = (bf16_t*)(ws + WS_A2); bf16_t* TB = (bf16_t*)(ws + WS_TB);
    bf16_t* MIX = (bf16_t*)(ws + WS_MIX); bf16_t* GT = (bf16_t*)(ws + WS_GT); bf16_t* PART = (bf16_t*)(ws + WS_PART);
    float* SS2 = (float*)(ws + WS_SS2); float* LB = (float*)(ws + WS_LB); float* LAMT = (float*)(ws + WS_LAMT); float* BBT = (float*)(ws + WS_BBT); float* DL = (float*)(ws + WS_DL); float* ORAWS = (float*)(ws + WS_ORAWS); unsigned* CNT = (unsigned*)(ws + WS_CNT); unsigned* CNTP = (unsigned*)(ws + WS_CNTP); unsigned* CNTS = (unsigned*)(ws + WS_CNTS); float* SLOC = (float*)(ws + WS_SLOC); float* DSEG = (float*)(ws + WS_DSEG);
    float* X1 = out + O_YP;
    float* o_hp = (a.omask & 4) ? out + O_HP : nullptr; float* o_rp = (a.omask & 8) ? out + O_RP : nullptr; float* o_ip = (a.omask & 16) ? out + O_IP : nullptr;
    float* o_hs = (a.omask & 32) ? out + O_HS : nullptr; float* o_rs = (a.omask & 64) ? out + O_RS : nullptr; float* o_is = (a.omask & 128) ? out + O_IS : nullptr;
    const int lo = a.ph_lo, hi = a.ph_hi;
#ifdef PROBE_TS
    unsigned long long* ts = (unsigned long long*)(ws + WS_MISC + MiB + 768 * 1024);
#define TS(slot, cond) do { if (tid == 0 && (cond)) ts[slot] = __builtin_amdgcn_s_memrealtime(); } while (0)
#else
#define TS(slot, cond) do { } while (0)
#endif
    TS(0, blk == 0);
#define IN(k) (lo <= (k) && (k) < hi)
#define SEAM(k) do { if (IN(k) && IN((k) + 1) && a.coop) grid.sync(); TS((k) + 1, blk == 0); } while (0)

    if (IN(0)) {
        if (G < 256) for (int it = blk; it < 256; it += G) s5_table_item(it >> 2, it & 3, a.in[11], a.in[12], a.in[13], a.in[14], a.in[15], a.in[16], a.in[17], a.in[18], TB, GT, LAMT, BBT, (LAS float*)lds, tid);
        for (int i = blk * 512 + tid; i < NTOK; i += G * 512) SS2[i] = 0.f;
        for (int i = blk * 512 + tid; i < pg8::L_NLINES * 64; i += G * 512) CNT[i] = 0u;
        for (int i = blk * 512 + tid; i < 3072; i += G * 512) CNTP[i] = 0u;
        for (int i = blk * 512 + tid; i < WA; i += G * 512) { const float e0 = __expf(a.in[9][i]), e1 = __expf(a.in[9][WA + i]); LB[i] = e0 / (e0 + e1); }
        LAS float* scr = (LAS float*)(lds + wave * TR_WAVE_LDS);
        constexpr int I_IN = (DM / 64) * (INC / 64), I_GLU = (WA / 64) * (WA / 64), I_OUT = (DM / 64) * (DM / 64);
        unsigned* cntH = (unsigned*)(ws + WS_CNT1); unsigned* cntW = cntH + 64 * 34;
        for (int it = gw; it < I_IN + I_GLU; it += NGW) {
            if (it < I_IN) { transpose_item<true, true>(a.in[5], DM, INC, WTIN, scr, it, lane, nullptr);
                asm volatile("s_waitcnt vmcnt(0)" ::: "memory"); if (lane == 0) __hip_atomic_fetch_add(cntW + 64 * (it >> 7), 1u, __ATOMIC_RELAXED, __HIP_MEMORY_SCOPE_AGENT); }
            else transpose_item(a.in[19], WA, WA, WTGLU, scr, it - I_IN, lane, nullptr);
        }
        for (int r = gw; r < NTOK; r += NGW) { rms_row_bf16(r < NPROMPT ? x_p + (size_t)r * DM : x_s + (size_t)(r - NPROMPT) * DM, a.in[7], HB + (size_t)r * DM, lane);
            asm volatile("s_waitcnt vmcnt(0)" ::: "memory"); if (lane == 0) __hip_atomic_fetch_add(cntH + 64 * (r >> 8), 1u, __ATOMIC_RELAXED, __HIP_MEMORY_SCOPE_AGENT); }
        __syncthreads();
    }
    TS(1, blk == 0);
    if (IN(1)) {
        pg8::Gemm g{HB, WTIN, DM, DM, DM}; pg8::TileOrderDep S; S.init(NTOK, INC, 1, G, blk); S.cntH = (const unsigned*)(ws + WS_CNT1); S.cntW = S.cntH + 64 * 34;
        pg8::Epi1 E{ws, a.in[9]};
        pg8::gemm_phase<pg8::Epi1, pg8::TileOrderDep, true, true>(lds, g, S, E);
        __syncthreads();
        if (G >= 256) for (int it = blk - 168; it >= 0 && it < 256; it += G - 168) s5_table_item(it >> 2, it & 3, a.in[11], a.in[12], a.in[13], a.in[14], a.in[15], a.in[16], a.in[17], a.in[18], TB, GT, LAMT, BBT, (LAS float*)lds, tid);
    }
    SEAM(1);
    if (IN(2)) {
        { pg8::Gemm g{UG, GT, 512, 640, 512}; pg8::GroupOrder S{0, 64, 1, G, blk, (size_t)256 * 640, (size_t)256 * 512, 0}; pg8::EpiS1 E{XLOC};
          pg8::gemm_phase<pg8::EpiS1, pg8::GroupOrder, true, true>(lds, g, S, E); }
        __syncthreads(); TS(22, blk == 0);
        for (int gg = blk; gg < 64; gg += G) s5_scan(gg, XLOC, LAMT, UG, o_rp, o_ip, CNTS, tid);   TS(23, blk == 0);
        {
            int it, step, last;
            if (G == 256) { if (blk >= 64) { it = blk - 64; step = 192; last = 960; } else { it = 960 + blk; step = 1024; last = 1024; } } else { it = blk; step = G; last = 1024; }
            float lfA[16], lfB[16]; bf16_t qA[16], qB[16], vA[16], vB[16];
            if (it < last) hgrn_pre_load(it, LF, QB, VB, lfA, qA, vA, tid);
            while (it < last) { const int nx = it + step;
                if (nx < last) hgrn_pre_load(nx, LF, QB, VB, lfB, qB, vB, tid);
                hgrn_pre_compute(it, lfA, qA, vA, PRE, DL, CNTP, (LAS float*)lds, tid);
#pragma unroll
                for (int i = 0; i < 16; ++i) { lfA[i] = lfB[i]; qA[i] = qB[i]; vA[i] = vB[i]; }
                it = nx; }
        }
        __syncthreads();
    }
    TS(3, blk == 0);
    if (IN(3)) {
        int s0, per;
        if (blk < 128) { TS(16, blk == 0); if (!(a.omask & 256)) hgrn_chain(blk >> 5, (blk >> 2) & 7, blk & 3, PRE, DL, ORAW, SLOC, DSEG, CNTP, lds, tid); TS(17, blk == 0); s0 = blk * 4; per = 4; }
        else { const int j = blk - 128; s0 = 512 + j * 4; per = 4;
            if (!(a.omask & 512)) { const int g = j >> 1;
                if (tid == 0) { while (__hip_atomic_load(CNTS + 16 * g, __ATOMIC_RELAXED, __HIP_MEMORY_SCOPE_AGENT) < 1u) __builtin_amdgcn_s_sleep(4);
                    __builtin_amdgcn_fence(__ATOMIC_ACQUIRE, "agent"); asm volatile("s_waitcnt vmcnt(0)" ::: "memory"); }
                __syncthreads();
                pg8::Gemm gm{UG, TB, 640, 640, 640}; pg8::GroupOrder S{g, 1, 1, 1, 0, (size_t)256 * 640, (size_t)512 * 640, j & 1}; pg8::EpiS2 E{YBUF};
                pg8::gemm_phase<pg8::EpiS2, pg8::GroupOrder, true, true>(lds, gm, S, E); __syncthreads(); TS(18, blk == 128); } }
        if (!(a.omask & 1024)) {
            f32x4 SA[8], SB[8]; float fA = 0.f, fB = 0.f; bf16_t qA = 0, qB = 0, vA = 0, vB = 0;
            hgrn_sample_load(s0, LF, QB, VB, a.in[2], SA, fA, qA, vA, tid);
            for (int n = 0; n < per; ++n) {
                if (n + 1 < per) hgrn_sample_load(s0 + n + 1, LF, QB, VB, a.in[2], SB, fB, qB, vB, tid);
                hgrn_sample_compute(s0 + n, SA, fA, qA, vA, ORAWS, o_hs, (LAS float*)lds, tid);
#pragma unroll
                for (int i = 0; i < 8; ++i) SA[i] = SB[i];
                fA = fB; qA = qB; vA = vB; }
            TS(19, blk == 128); TS(20, blk == 0);
            for (int n = 0; n < per; ++n) s5_sample_item(s0 + n, US, LAMT, BBT, a.in[15], a.in[16], a.in[17], a.in[3], a.in[4], YBUF, o_rs, o_is, (LAS float*)lds, tid);
            TS(21, blk == 128); TS(24, blk == 0);
        }
        __syncthreads();
    }
    SEAM(3);
    if (IN(4)) {
        TS(14, blk == 2);
        if (blk < 96) { const int bh = blk / 3, sg = 1 + blk % 3; hgrn_corr(bh >> 3, bh & 7, sg, PRE, DL, SLOC, DSEG, ORAW, o_hp, CNT + 64 * pg8::L_CALL, lds, tid); TS(15, blk == 2); }
        else if (blk < 232) { pg8::Gemm g{YBUF, WTGLU, WA, WA, WA}; pg8::TileOrderPub S; S.init(NTOK, WA, 1, 136, blk - 96); S.cnt = CNT + 64 * pg8::L_CL; pg8::EpiGlu E{YBUF, a.in[20], MIX};
            pg8::gemm_phase<pg8::EpiGlu, pg8::TileOrderPub, true, true>(lds, g, S, E); }
        __syncthreads();
        constexpr int I_UP = (DM / 64) * (DFF / 64), I_DN = (DFF / 64) * (DM / 64), I_WO = (DM / 64) * (DM / 64);
        LAS float* scr = (LAS float*)(lds + wave * TR_WAVE_LDS);
        const int ncw = (G - 96) * 8, cw = (blk - 96) * 8 + wave;
#define COPY_WO_WD() do { for (int it = ncw - 1 - cw; it < I_WO + I_DN; it += ncw) { \
            if (it < I_WO) { transpose_item<true, true>(a.in[6], DM, DM, WTOUT, scr, it, lane, nullptr); \
                asm volatile("s_waitcnt vmcnt(0)" ::: "memory"); if (lane == 0) __hip_atomic_fetch_add(CNT + 64 * (pg8::L_WO + (it >> 7)), 1u, __ATOMIC_RELAXED, __HIP_MEMORY_SCOPE_AGENT); } \
            else { const int id = it - I_WO; transpose_item<true, true>(a.in[22], DFF, DM, WTDOWN, scr, id, lane, nullptr); \
                asm volatile("s_waitcnt vmcnt(0)" ::: "memory"); if (lane == 0) __hip_atomic_fetch_add(CNT + 64 * (pg8::L_WD + (id >> 9)), 1u, __ATOMIC_RELAXED, __HIP_MEMORY_SCOPE_AGENT); } } } while (0)
        if (blk >= 96) COPY_WO_WD();
        __syncthreads();
        if (tid == 0) { while (__hip_atomic_load(CNT + 64 * pg8::L_CALL, __ATOMIC_RELAXED, __HIP_MEMORY_SCOPE_AGENT) < 96u * 8u) __builtin_amdgcn_s_sleep(4);
            __builtin_amdgcn_fence(__ATOMIC_ACQUIRE, "agent"); asm volatile("s_waitcnt vmcnt(0)" ::: "memory"); }
        __syncthreads();
        for (int r = gw; r < NTOK; r += NGW) { gate_row(r, ORAW, ORAWS, GB, a.in[10], MIX, lane);
            asm volatile("s_waitcnt vmcnt(0)" ::: "memory"); if (lane == 0) __hip_atomic_fetch_add(CNT + 64 * (pg8::L_CG + (r >> 8)), 1u, __ATOMIC_RELAXED, __HIP_MEMORY_SCOPE_AGENT); }
        if (lane == 0) __hip_atomic_fetch_add(CNT + 64 * pg8::L_TOT, 1u, __ATOMIC_RELAXED, __HIP_MEMORY_SCOPE_AGENT);
#undef COPY_WO_WD
        if (blk >= 96) for (int iu = cw; iu < I_UP; iu += ncw) { transpose_item<true, true>(a.in[21], DM, DFF, WTUP, scr, iu, lane, a.in[8]);
            asm volatile("s_waitcnt vmcnt(0)" ::: "memory"); if (lane == 0) __hip_atomic_fetch_add(CNT + 64 * (pg8::L_WU + (iu >> 7)), 1u, __ATOMIC_RELAXED, __HIP_MEMORY_SCOPE_AGENT); }
        __syncthreads(); }
    TS(5, blk == 0);
    if (IN(5)) {
        { pg8::Gemm g{MIX, WTOUT, DM, DM, DM}; pg8::FfnOrder S{3, G, (blk + G - 232) % G, CNT, (unsigned)NGW}; pg8::EpiOut E{x_p, x_s, X1, A2, SS2};
          pg8::gemm_phase<pg8::EpiOut, pg8::FfnOrder, true, true>(lds, g, S, E); }
        TS(10, blk == 0);
        { pg8::Gemm g{A2, WTUP, DM, DM, DM}; pg8::FfnOrder S{4, G, (blk + G - 96) % G, CNT, (unsigned)NGW}; pg8::EpiUp E{SS2, HH};
          pg8::gemm_phase<pg8::EpiUp, pg8::FfnOrder, true, true>(lds, g, S, E); }
        TS(11, blk == 0);
        { pg8::Gemm g{HH, WTDOWN, DM, DFF, DFF}; pg8::FfnOrder S{6, G, (blk + G - 160) % G, CNT, (unsigned)NGW}; pg8::EpiDown E{ws};
          pg8::gemm_phase<pg8::EpiDown, pg8::FfnOrder, true, true>(lds, g, S, E); }
        TS(12, blk == 0);
        for (int r0 = blk * 8; r0 < NTOK; r0 += NGW) {
            if (tid == 0) { const unsigned* wd = CNT + 64 * (pg8::L_CP + (r0 >> 8));
                while (__hip_atomic_load(wd, __ATOMIC_RELAXED, __HIP_MEMORY_SCOPE_AGENT) < 256u) __builtin_amdgcn_s_sleep(4);
                __builtin_amdgcn_fence(__ATOMIC_ACQUIRE, "agent"); asm volatile("s_waitcnt vmcnt(0)" ::: "memory"); }
            __syncthreads();
            final_row(r0 + wave, X1, ws, a.in[23], lane); }
        __syncthreads(); TS(13, blk == 0);
    }
#ifdef PROBE_TS
    if (a.coop && blk == 0 && tid == 0) {
        const unsigned long long dt = ts[PROBE_B] - ts[PROBE_A], t0 = __builtin_amdgcn_s_memrealtime();
        while (__builtin_amdgcn_s_memrealtime() - t0 < dt * PROBE_AMP) __builtin_amdgcn_s_sleep(8); }
#endif
#undef IN
#undef SEAM
}

static int mk_grid = 0;
static void mk_setup() {
    if (mk_grid) return;
    int dev = 0, cus = 0, per_cu = 0;
    (void)hipGetDevice(&dev); (void)hipDeviceGetAttribute(&cus, hipDeviceAttributeMultiprocessorCount, dev);
    (void)hipFuncSetAttribute((const void*)mk, hipFuncAttributeMaxDynamicSharedMemorySize, LDS_BYTES);
    (void)hipOccupancyMaxActiveBlocksPerMultiprocessor(&per_cu, (const void*)mk, 512, LDS_BYTES);
    (void)hipGetLastError();
    mk_grid = cus > 0 ? cus : 256;
    fprintf(stderr, "mk_setup: cus %d per_cu %d grid %d\n", cus, per_cu, mk_grid);
}
static void mk_launch(void* const* d_in, void* d_out, void* d_ws, hipStream_t stream, int lo, int hi, int coop, int omask) {
    mk_setup();
    Args a{};
    for (int i = 0; i < 24; ++i) a.in[i] = (const float*)d_in[i];
    a.out = (float*)d_out; a.ws = (unsigned char*)d_ws; a.ph_lo = lo; a.ph_hi = hi; a.coop = coop; a.omask = omask;
    void* args[] = {&a};
    hipError_t e;
    if (coop) (void)hipMemsetAsync((unsigned char*)d_ws + WS_CNT1, 0, 54 * 256, stream);
    if (coop) e = hipLaunchCooperativeKernel((const void*)mk, dim3(mk_grid), dim3(512), args, LDS_BYTES, stream);
    else { hipLaunchKernelGGL(mk, dim3(mk_grid), dim3(512), LDS_BYTES, stream, a); e = hipPeekAtLastError(); }
    if (e != hipSuccess) fprintf(stderr, "mk launch failed: %s (grid %d, phases %d..%d)\n", hipGetErrorString(e), mk_grid, lo, hi);
}
extern "C" void kernel_launch(void* const* d_in, const int* in_sizes, int n_in, void* d_out, int out_size, void* d_ws, size_t ws_size, hipStream_t stream) {
    if (ws_size < WS_END || n_in < 24) { fprintf(stderr, "kernel_launch: ws %zu < %zu or n_in %d < 24; nothing launched\n", ws_size, (size_t)WS_END, n_in); return; }
#ifdef PROBE_MASK
#ifndef PROBE_SKIP
#define PROBE_SKIP 0
#endif
    for (int k = 0; k < NPH; ++k) if ((PROBE_MASK >> k) & 1) mk_launch(d_in, d_out, d_ws, stream, k, k + 1, 0, PROBE_SKIP);
#endif
    mk_launch(d_in, d_out, d_ws, stream, 0, NPH, 1, 0xFF);
}
```
